# Optimizing an MI355X kernel written in HIP

```python
import math
import jax, jax.numpy as jnp
from jax import lax
import numpy as np

D_MODEL = 1024
BATCH = 1
SEQ = 16384
DEPTH = 1

ATTN_GROUPS = ((128, 1), (512, 4), (2048, 16))
N_GROUPS = len(ATTN_GROUPS)
HEADS_PER_GROUP = 8
HEAD_DIM = 64
ATTN_HEADS = N_GROUPS * HEADS_PER_GROUP
ATTN_WIDTH = ATTN_HEADS * HEAD_DIM
ATTN_OUT = HEADS_PER_GROUP * HEAD_DIM
ATTN_BLOCK = 64
REL_BUCKETS = 32
REL_MAX_DIST = 1024
HGRN_EXPAND = 128
HGRN_HEADS = D_MODEL // HGRN_EXPAND
HGRN_KDIM = HGRN_EXPAND
HGRN_VDIM = D_MODEL // HGRN_HEADS
HGRN_WIDTH = HGRN_HEADS * HGRN_KDIM
HGRN_CHUNK = 64
D_FF = 2816
N_BRANCHES = 2
EPS = 1e-6
NEG_INF = -1e30

IN_SPLITS = (ATTN_WIDTH,) * 3 + (HGRN_WIDTH,) * 5 + (D_MODEL,) * N_BRANCHES
IN_WIDTH = sum(IN_SPLITS)
IN_OFFSETS = tuple(int(v) for v in np.cumsum(IN_SPLITS)[:-1])

kernel_name = 'hybrid_dilated_attn_hgrn2_macaron_block'


def rmsnorm(x, g):
    xf = x.astype(jnp.float32)
    y = xf * lax.rsqrt(jnp.mean(xf * xf, axis=-1, keepdims=True) + EPS)
    return (y * g.astype(jnp.float32)).astype(x.dtype)


def swiglu(x, w_in, w_out):
    gate, up = jnp.split(x @ w_in, 2, axis=-1)
    return (jax.nn.silu(gate) * up) @ w_out


def t5_bucket(rel):
    nb = REL_BUCKETS // 2
    max_exact = nb // 2
    ret = jnp.where(rel > 0, nb, 0)
    n = jnp.abs(rel)
    nf = jnp.maximum(n, 1).astype(jnp.float32)
    large = max_exact + (jnp.log(nf / max_exact) / math.log(REL_MAX_DIST / max_exact)
                         * (nb - max_exact)).astype(jnp.int32)
    large = jnp.minimum(large, nb - 1)
    return ret + jnp.where(n < max_exact, n, large)


def dilated_group_attention(q, k, v, bias_table, window, dilation):
    B, S, Hg, hd = q.shape
    half = window // (2 * dilation)
    L = S // dilation
    nb = -(-L // ATTN_BLOCK)
    Lp = nb * ATTN_BLOCK

    def to_sub(t):
        return t.reshape(B, L, dilation, Hg, hd).transpose(0, 2, 3, 1, 4)

    qs = jnp.pad(to_sub(q), ((0, 0),) * 3 + ((0, Lp - L), (0, 0)))
    pad_kv = ((0, 0),) * 3 + ((ATTN_BLOCK, Lp - L + ATTN_BLOCK), (0, 0))
    ks = jnp.pad(to_sub(k), pad_kv)
    vs = jnp.pad(to_sub(v), pad_kv)
    qb = qs.reshape(B, dilation, Hg, nb, ATTN_BLOCK, hd)

    def band(t):
        tb = t.reshape(B, dilation, Hg, nb + 2, ATTN_BLOCK, hd)
        return jnp.concatenate([tb[:, :, :, :nb], tb[:, :, :, 1:nb + 1], tb[:, :, :, 2:]], axis=-2)

    kb, vb = band(ks), band(vs)
    t_idx = jnp.arange(ATTN_BLOCK)[:, None]
    c_idx = jnp.arange(3 * ATTN_BLOCK)[None, :]
    delta = c_idx - ATTN_BLOCK - t_idx
    key_sub = jnp.arange(nb)[:, None, None] * ATTN_BLOCK + c_idx[None] - ATTN_BLOCK
    valid = (jnp.abs(delta) <= half)[None] & (key_sub >= 0) & (key_sub < L)
    bias = jnp.moveaxis(bias_table.astype(jnp.float32)[t5_bucket(delta * dilation)], -1, 0)

    s = jnp.einsum('bdhnqe,bdhnke->bdhnqk', qb, kb).astype(jnp.float32) * (HEAD_DIM ** -0.5)
    s = s + bias[None, None, :, None]
    s = jnp.where(valid[None, None, None], s, NEG_INF)
    lse = jax.nn.logsumexp(s, axis=-1)
    p = jnp.exp(s - lse[..., None])
    o = jnp.einsum('bdhnqk,bdhnke->bdhnqe', p.astype(v.dtype), vb)
    o = o.reshape(B, dilation, Hg, Lp, hd)[:, :, :, :L]
    lse = lse.reshape(B, dilation, Hg, Lp)[..., :L]
    o = o.transpose(0, 3, 1, 2, 4).reshape(B, S, Hg, hd)
    lse = lse.transpose(0, 3, 1, 2).reshape(B, S, Hg)
    return o, lse


def hgrn2_chunk_scan(q, k, v, logf):
    B, S, H, K = q.shape
    V = v.shape[-1]
    C = HGRN_CHUNK
    N = S // C

    def r(t):
        return t.reshape(B, N, C, H, t.shape[-1]).transpose(0, 3, 1, 2, 4)

    q, k, v, logf = r(q), r(k), r(v), r(logf)
    b = jnp.cumsum(logf, axis=3)
    ref = b[:, :, :, C // 2:C // 2 + 1]
    a = jnp.einsum('bhnck,bhnsk->bhncs', q * jnp.exp(b - ref), k * jnp.exp(ref - b))
    tri = jnp.tril(jnp.ones((C, C), dtype=bool))
    a = jnp.where(tri, a, 0.0)
    o_intra = jnp.einsum('bhncs,bhnsv->bhncv', a, v)
    b_last = b[:, :, :, -1:]
    u = jnp.einsum('bhnck,bhncv->bhnkv', k * jnp.exp(b_last - b), v)
    decay = jnp.exp(b_last[:, :, :, 0])

    def step(state, inp):
        d, du = inp
        return d[..., None] * state + du, state

    s0 = jnp.zeros((B, H, K, V), jnp.float32)
    _, s_start = lax.scan(step, s0, (decay.transpose(2, 0, 1, 3), u.transpose(2, 0, 1, 3, 4)))
    s_start = s_start.transpose(1, 2, 0, 3, 4)
    o_inter = jnp.einsum('bhnck,bhnkv->bhncv', q * jnp.exp(b), s_start)
    o = o_intra + o_inter
    return o.transpose(0, 2, 3, 1, 4).reshape(B, S, H, V)


def hgrn2_bidirectional(qz, fz_f, fz_b, iz, gz, lb_f, lb_b, norm_w):
    B, S, _ = qz.shape
    shp_k = (B, S, HGRN_HEADS, HGRN_KDIM)
    q = jax.nn.silu(qz.astype(jnp.float32)).reshape(shp_k)
    v = iz.astype(jnp.float32).reshape(B, S, HGRN_HEADS, HGRN_VDIM)

    def gates(fz, lb):
        f = lb.astype(jnp.float32) + (1.0 - lb.astype(jnp.float32)) * jax.nn.sigmoid(fz.astype(jnp.float32))
        return (1.0 - f).reshape(shp_k), jnp.log(f).reshape(shp_k)

    k_f, logf_f = gates(fz_f, lb_f)
    k_b, logf_b = gates(fz_b, lb_b)
    o_fwd = hgrn2_chunk_scan(q, k_f, v, logf_f)
    flip = lambda t: jnp.flip(t, axis=1)
    o_bwd = flip(hgrn2_chunk_scan(flip(q), flip(k_b), flip(v), flip(logf_b)))
    o = o_fwd + o_bwd
    o = o * lax.rsqrt(jnp.mean(o * o, axis=-1, keepdims=True) + EPS) * norm_w.astype(jnp.float32)
    o = o * jax.nn.silu(gz.astype(jnp.float32).reshape(B, S, HGRN_HEADS, HGRN_VDIM))
    return o.reshape(B, S, HGRN_HEADS * HGRN_VDIM).astype(qz.dtype)


def hybrid_mixer(h, w_in, rel_bias, lb_f, lb_b, hgrn_norm, w_proj_attn, w_proj_hgrn, w_out):
    B, S, _ = h.shape
    z = h @ w_in
    qa, ka, va, qh, fz_f, fz_b, ih, gh, gate_a, gate_h = jnp.split(z, IN_OFFSETS, axis=-1)

    shp = (B, S, N_GROUPS, HEADS_PER_GROUP, HEAD_DIM)
    qa, ka, va = qa.reshape(shp), ka.reshape(shp), va.reshape(shp)
    bias = rel_bias.reshape(REL_BUCKETS, N_GROUPS, HEADS_PER_GROUP)
    outs, lses = [], []
    for g, (window, dil) in enumerate(ATTN_GROUPS):
        o, lse = dilated_group_attention(qa[:, :, g], ka[:, :, g], va[:, :, g], bias[:, g], window, dil)
        outs.append(o)
        lses.append(lse)
    alpha = jax.nn.softmax(jnp.stack(lses, axis=0), axis=0)
    y_a = jnp.einsum('gbsh,gbshe->bshe', alpha, jnp.stack(outs, axis=0).astype(jnp.float32))
    y_a = y_a.reshape(B, S, ATTN_OUT).astype(h.dtype)

    y_h = hgrn2_bidirectional(qh, fz_f, fz_b, ih, gh, lb_f, lb_b, hgrn_norm)

    y = jax.nn.sigmoid(gate_a) * (y_a @ w_proj_attn) + jax.nn.sigmoid(gate_h) * (y_h @ w_proj_hgrn)
    return y @ w_out


def setup_inputs(seed: int = 0) -> dict:
    key = jax.random.key(seed)
    ks = jax.random.split(key, 18)
    f32 = jnp.float32

    def w(k, shape, fan_in):
        return jax.random.normal(k, shape, f32) * fan_in ** -0.5

    def gain(k, shape):
        return 1.0 + 0.02 * jax.random.normal(k, shape, f32)

    L = DEPTH
    return {
        'x': jax.random.normal(ks[0], (BATCH, SEQ, D_MODEL), f32),
        'ffn1_pre_norm': gain(ks[1], (L, D_MODEL)),
        'w_ffn1_in': w(ks[2], (L, D_MODEL, 2 * D_FF), D_MODEL),
        'w_ffn1_out': w(ks[3], (L, D_FF, D_MODEL), D_FF),
        'ffn1_post_norm': gain(ks[4], (L, D_MODEL)),
        'mix_pre_norm': gain(ks[5], (L, D_MODEL)),
        'w_in': w(ks[6], (L, D_MODEL, IN_WIDTH), D_MODEL),
        'rel_bias': 0.2 * jax.random.normal(ks[7], (REL_BUCKETS, ATTN_HEADS), f32),
        'hgrn_lb': 0.5 * jax.random.normal(ks[8], (2, DEPTH + 1, HGRN_WIDTH), f32),
        'hgrn_norm': gain(ks[9], (L, HGRN_VDIM)),
        'w_proj_attn': w(ks[10], (L, ATTN_OUT, D_MODEL), ATTN_OUT),
        'w_proj_hgrn': w(ks[11], (L, HGRN_HEADS * HGRN_VDIM, D_MODEL), HGRN_HEADS * HGRN_VDIM),
        'w_out': w(ks[12], (L, D_MODEL, D_MODEL), D_MODEL),
        'mix_post_norm': gain(ks[13], (L, D_MODEL)),
        'ffn2_pre_norm': gain(ks[14], (L, D_MODEL)),
        'w_ffn2_in': w(ks[15], (L, D_MODEL, 2 * D_FF), D_MODEL),
        'w_ffn2_out': w(ks[16], (L, D_FF, D_MODEL), D_FF),
        'ffn2_post_norm': gain(ks[17], (L, D_MODEL)),
    }


def reference(x, ffn1_pre_norm, w_ffn1_in, w_ffn1_out, ffn1_post_norm, mix_pre_norm, w_in,
              rel_bias, hgrn_lb, hgrn_norm, w_proj_attn, w_proj_hgrn, w_out, mix_post_norm,
              ffn2_pre_norm, w_ffn2_in, w_ffn2_out, ffn2_post_norm):
    lb_all = jnp.cumsum(jax.nn.softmax(hgrn_lb.astype(jnp.float32), axis=1), axis=1)
    for l in range(DEPTH):
        h = rmsnorm(x, ffn1_pre_norm[l])
        x = x + 0.5 * rmsnorm(swiglu(h, w_ffn1_in[l], w_ffn1_out[l]), ffn1_post_norm[l])

        h = rmsnorm(x, mix_pre_norm[l])
        y = hybrid_mixer(h, w_in[l], rel_bias, lb_all[0, l], lb_all[1, l], hgrn_norm[l],
                         w_proj_attn[l], w_proj_hgrn[l], w_out[l])
        x = x + rmsnorm(y, mix_post_norm[l])

        h = rmsnorm(x, ffn2_pre_norm[l])
        x = x + 0.5 * rmsnorm(swiglu(h, w_ffn2_in[l], w_ffn2_out[l]), ffn2_post_norm[l])
    return x
```

```cpp
#include <hip/hip_runtime.h>
#include <hip/hip_cooperative_groups.h>
#include <cstdio>
#include <cstdint>
namespace pg8 {
#define PG8_LAS __attribute__((address_space(3)))
typedef unsigned short bf16_t;
typedef short bf16x8 __attribute__((ext_vector_type(8)));
typedef float f32x4 __attribute__((ext_vector_type(4)));
typedef unsigned u32x4 __attribute__((ext_vector_type(4)));
constexpr int BM = 256, BK = 64, HALF = 128, HTB = HALF * BK * 2  , STAGE_BYTES = 8 * HTB, NXCD = 8, WGM = 8;

__host__ __device__ __forceinline__ int lds_byte(int r, int c) { const int st = (r >> 4) * 2 + (c >> 5), rr = r & 15, cc = c & 31, ob = rr * 64 + cc * 2; return st * 1024 + (ob ^ (((ob >> 9) & 1) << 5)); }
__host__ __device__ __forceinline__ void stage_rc(int b, int& R, int& C) { const int st = b / 1024, sb = b % 1024, swz = sb ^ (((sb >> 9) & 1) << 5); R = (st >> 1) * 16 + swz / 64; C = (st & 1) * 32 + (swz % 64) / 2; }
__host__ __device__ __forceinline__ int perm32(int rho) { const int n = rho >> 4, i = rho & 15; return 8 * (i >> 2) + 4 * n + (i & 3); }

struct Unit { int pm, pn; };
struct Gemm { const bf16_t* A; const bf16_t* Bt; int M, N, K; };

struct StaticOrder {
    int nM, nN, nwg, G, c;
    __host__ __device__ void init(int M, int N, int G_, int c_) { nM = M / BM; nN = N / BM; nwg = nM * nN; G = G_; c = c_; }
    __host__ __device__ bool next(int i, Unit& u) const {
        const long L = (long)i * G + c; if (L >= nwg) return false;
        int wgid = (int)L; { const int q = nwg / NXCD, r = nwg % NXCD, xcd = wgid % NXCD, off = wgid / NXCD; wgid = (xcd < r ? xcd * (q + 1) : r * (q + 1) + (xcd - r) * q) + off; }
        const int nig = WGM * nN, gid = wgid / nig, fm = gid * WGM, gsz = (nM - fm) < WGM ? (nM - fm) : WGM;
        u.pm = fm + ((wgid % nig) % gsz); u.pn = (wgid % nig) / gsz; return true;
    }
    __device__ __forceinline__ void a_ready(const Unit&) const {}
    __device__ __forceinline__ void done(const Unit&) const {}
};

__device__ __forceinline__ unsigned cvt_pk_bf16(float lo, float hi) { unsigned r; asm volatile("v_cvt_pk_bf16_f32 %0, %1, %2" : "=v"(r) : "v"(lo), "v"(hi)); return r; }
typedef float f32x2 __attribute__((ext_vector_type(2)));
typedef __bf16 bf16x2v __attribute__((ext_vector_type(2)));
__device__ __forceinline__ unsigned pk2(float lo, float hi) { f32x2 v = {lo, hi}; bf16x2v b = __builtin_convertvector(v, bf16x2v); return __builtin_bit_cast(unsigned, b); }
__device__ __forceinline__ float bflo(unsigned w) { return __uint_as_float(w << 16); }
__device__ __forceinline__ float bfhi(unsigned w) { return __uint_as_float(w & 0xffff0000u); }
__device__ __forceinline__ float sigmoid_f(float x) { return __builtin_amdgcn_rcpf(1.0f + __builtin_amdgcn_exp2f(-1.4426950408889634f * x)); }
__device__ __forceinline__ float silu_f(float x) { return x * sigmoid_f(x); }
__device__ __forceinline__ u32x4 pack8(const f32x4& a, const f32x4& b) { u32x4 w; w.x = pk2(a[0], a[1]); w.y = pk2(a[2], a[3]); w.z = pk2(b[0], b[1]); w.w = pk2(b[2], b[3]); return w; }

struct EpiSwiglu {
    static constexpr bool PERM = true, AFTER_DRAIN = false;
    bf16_t* O; int ldc;
    __device__ __forceinline__ void operator()(const f32x4 (&acc)[2][2][4][2], const Unit& u, int wr, int wc, int fr, int fq) const {
        const int row0 = u.pm * BM + wr * 64 + fr, col0 = u.pn * HALF + wc * 32 + 8 * fq;
#pragma unroll
        for (int ai = 0; ai < 2; ++ai)
#pragma unroll
            for (int m = 0; m < 4; ++m) {
                bf16_t* rowp = O + (size_t)(row0 + ai * HALF + m * 16) * ldc + col0;
                f32x4 r0, r1;
#pragma unroll
                for (int i = 0; i < 4; ++i) { r0[i] = silu_f(acc[ai][0][m][0][i]) * acc[ai][1][m][0][i]; r1[i] = silu_f(acc[ai][0][m][1][i]) * acc[ai][1][m][1][i]; }
                *(u32x4*)rowp = pack8(r0, r1);
            }
    }
};
struct EpiF32 {
    static constexpr bool PERM = false, AFTER_DRAIN = false;
    float* O; int ldc;
    __device__ __forceinline__ void operator()(const f32x4 (&acc)[2][2][4][2], const Unit& u, int wr, int wc, int fr, int fq) const {
        const int row0 = u.pm * BM + wr * 64 + fr, col0 = u.pn * BM + wc * 32 + 4 * fq;
#pragma unroll
        for (int ai = 0; ai < 2; ++ai)
#pragma unroll
            for (int m = 0; m < 4; ++m) {
                float* rowp = O + (size_t)(row0 + ai * HALF + m * 16) * ldc + col0;
#pragma unroll
                for (int bj = 0; bj < 2; ++bj)
#pragma unroll
                    for (int n = 0; n < 2; ++n) *(f32x4*)(rowp + bj * HALF + n * 16) = acc[ai][bj][m][n];
            }
    }
};
template <int MODE> struct EpiSect {
    static constexpr bool PERM = true, AFTER_DRAIN = false;
    bf16_t* O; int sec_cols; size_t sec_stride; float scale0; const float* lbraw;
    __device__ __forceinline__ void operator()(const f32x4 (&acc)[2][2][4][2], const Unit& u, int wr, int wc, int fr, int fq) const {
        const int row0 = u.pm * BM + wr * 64 + fr; const int colt = u.pn * BM; const int sec = colt / sec_cols; const int ch0 = colt - sec * sec_cols + wc * 32 + 8 * fq;
        bf16_t* base = O + (size_t)sec * sec_stride;
        int grp = 0, hbase = 0, cin = ch0;
        if (MODE == 0) { grp = ch0 >> 9; hbase = (ch0 >> 6) & 7; cin = ch0 & 63; }
        if (MODE == 1) { hbase = ch0 >> 7; cin = ch0 & 127; }
        float lb[2][8];
        if (MODE == 1 && (sec == 1 || sec == 2)) {
#pragma unroll
            for (int bj = 0; bj < 2; ++bj)
#pragma unroll
                for (int i = 0; i < 8; ++i) { const int ch = ch0 + bj * HALF + i; lb[bj][i] = sigmoid_f(lbraw[(sec - 1) * 2048 + ch] - lbraw[(sec - 1) * 2048 + 1024 + ch]); }
        }
#pragma unroll
        for (int ai = 0; ai < 2; ++ai)
#pragma unroll
            for (int m = 0; m < 4; ++m) {
                const int row = row0 + ai * HALF + m * 16;
                bf16_t* rowp = base + (size_t)row * sec_cols + ch0; size_t bjstep = HALF;
                if (MODE == 0) { const int dsh = 2 * grp, sidx = ((row & ((1 << dsh) - 1)) << (14 - dsh)) + (row >> dsh);
                    rowp = base + ((size_t)((grp * 8 + hbase) * 16384 + sidx) << 6) + cin; bjstep = (size_t)2 * 16384 * 64; }
                if (MODE == 1) { rowp = base + ((size_t)(hbase * 16384 + row) << 7) + cin; bjstep = (size_t)16384 * 128; }
#pragma unroll
                for (int bj = 0; bj < 2; ++bj) {
                    f32x4 v0 = acc[ai][bj][m][0], v1 = acc[ai][bj][m][1];
                    if (MODE == 0) { if (sec == 0) { v0 = v0 * scale0; v1 = v1 * scale0; } }
                    else if (MODE == 3) { }
                    else if (MODE == 2) {
#pragma unroll
                        for (int i = 0; i < 4; ++i) { v0[i] = sigmoid_f(v0[i]); v1[i] = sigmoid_f(v1[i]); }
                    } else {
                        if (sec == 0 || sec == 4) {
#pragma unroll
                            for (int i = 0; i < 4; ++i) { v0[i] = silu_f(v0[i]); v1[i] = silu_f(v1[i]); }
                        } else if (sec == 1 || sec == 2) {
#pragma unroll
                            for (int i = 0; i < 4; ++i) {
                                v0[i] = log1pf(-(1.0f - lb[bj][i]) * sigmoid_f(-v0[i])); v1[i] = log1pf(-(1.0f - lb[bj][4 + i]) * sigmoid_f(-v1[i])); }
                        }
                    }
                    *(u32x4*)(rowp + bj * bjstep) = pack8(v0, v1);
                }
            }
    }
};
template <bool ADD> struct EpiGated {
    static constexpr bool PERM = true, AFTER_DRAIN = false;
    bf16_t* O; const bf16_t* G; const bf16_t* T; int ldc;
    __device__ __forceinline__ void operator()(const f32x4 (&acc)[2][2][4][2], const Unit& u, int wr, int wc, int fr, int fq) const {
        const int row0 = u.pm * BM + wr * 64 + fr, col0 = u.pn * BM + wc * 32 + 8 * fq;
#pragma unroll
        for (int ai = 0; ai < 2; ++ai)
#pragma unroll
            for (int m = 0; m < 4; ++m) {
                const size_t off = (size_t)(row0 + ai * HALF + m * 16) * ldc + col0;
#pragma unroll
                for (int bj = 0; bj < 2; ++bj) {
                    const u32x4 gw = *(const u32x4*)(G + off + bj * HALF);
                    f32x4 v0 = acc[ai][bj][m][0], v1 = acc[ai][bj][m][1];
                    v0[0] *= bflo(gw.x); v0[1] *= bfhi(gw.x); v0[2] *= bflo(gw.y); v0[3] *= bfhi(gw.y);
                    v1[0] *= bflo(gw.z); v1[1] *= bfhi(gw.z); v1[2] *= bflo(gw.w); v1[3] *= bfhi(gw.w);
                    if (ADD) { const u32x4 tw = *(const u32x4*)(T + off + bj * HALF);
                        v0[0] += bflo(tw.x); v0[1] += bfhi(tw.x); v0[2] += bflo(tw.y); v0[3] += bfhi(tw.y);
                        v1[0] += bflo(tw.z); v1[1] += bfhi(tw.z); v1[2] += bflo(tw.w); v1[3] += bfhi(tw.w); }
                    *(u32x4*)(O + off + bj * HALF) = pack8(v0, v1);
                }
            }
    }
};
template <class Epi, class Sched, bool ALIGN_EPI = false, bool SP2 = false>
__device__ __forceinline__ void gemm_phase(PG8_LAS unsigned char* lds, const Gemm g, const Sched& S, const Epi& E) {
    const int tid = threadIdx.x, wid = __builtin_amdgcn_readfirstlane(tid >> 6), lane = tid & 63, wr = wid >> 2, wc = wid & 3, fr = lane & 15, fq = lane >> 4;
    const int K = g.K, nt = K / BK;
    unsigned voffA[2], voffB[2];
#pragma unroll
    for (int i = 0; i < 2; ++i) { int R, C; stage_rc(tid * 16 + i * 8192, R, C); const int Rb = Epi::PERM ? ((R & ~31) + perm32(R & 31)) : R;
        voffA[i] = (unsigned)(R * K + C) * 2u; voffB[i] = (unsigned)(Rb * K + C) * 2u; }
    const size_t kstep = (size_t)(BK * 2);
    const size_t hstep = (size_t)HALF * K * 2;
    const size_t tstep = 2 * hstep;
    const unsigned ldsw = (unsigned)wid * 1024u;
    const int aoff = lds_byte(wr * 64 + fr, fq * 8), boff = lds_byte(wc * 32 + fr, fq * 8);
#define PG8_SA(b, h) (((b) * 2 + (h)) * HTB)
#define PG8_SB(b, h) ((4 + (b) * 2 + (h)) * HTB)
#define PG8_STAGE(bufoff, gbase, voff) do { _Pragma("unroll") for (int _i = 0; _i < 2; ++_i) \
        __builtin_amdgcn_global_load_lds((const unsigned*)((const char*)(gbase) + (voff)[_i]), (PG8_LAS unsigned*)(lds + (bufoff) + ldsw + _i * 8192), 16, 0, 0); } while (0)
#define PG8_LDA(dst, b, h) do { _Pragma("unroll") for (int m = 0; m < 4; ++m) _Pragma("unroll") for (int k = 0; k < 2; ++k) dst[m][k] = *(const PG8_LAS bf16x8*)(lds + PG8_SA(b, h) + aoff + m * 2048 + k * 1024); } while (0)
#define PG8_LDB(dst, b, h) do { _Pragma("unroll") for (int n = 0; n < 2; ++n) _Pragma("unroll") for (int k = 0; k < 2; ++k) dst[n][k] = *(const PG8_LAS bf16x8*)(lds + PG8_SB(b, h) + boff + n * 2048 + k * 1024); } while (0)
#define PG8_MMA(ai, bj, At, Bt) do { __builtin_amdgcn_s_setprio(1); _Pragma("unroll") for (int m = 0; m < 4; ++m) _Pragma("unroll") for (int n = 0; n < 2; ++n) _Pragma("unroll") for (int k = 0; k < 2; ++k) \
        acc[ai][bj][m][n] = __builtin_amdgcn_mfma_f32_16x16x32_bf16(Bt[n][k], At[m][k], acc[ai][bj][m][n], 0, 0, 0); __builtin_amdgcn_s_setprio(0); } while (0)
#define PG8_WAIT_V(n) asm volatile("s_waitcnt vmcnt(" #n ")" ::: "memory")
#define PG8_WAIT_L(n) asm volatile("s_waitcnt lgkmcnt(" #n ")" ::: "memory")
#define PG8_BAR __builtin_amdgcn_s_barrier()
#define PG8_SCHED __builtin_amdgcn_sched_barrier(0)
    Unit cur, nxt; int ui = 0;
    if (!S.next(0, cur)) return;
    f32x4 acc[2][2][4][2];
#pragma unroll
    for (int a = 0; a < 2; ++a)
#pragma unroll
        for (int b = 0; b < 2; ++b)
#pragma unroll
            for (int m = 0; m < 4; ++m)
#pragma unroll
                for (int n = 0; n < 2; ++n) acc[a][b][m][n] = (f32x4){0.f, 0.f, 0.f, 0.f};
    bf16x8 At[4][2], B0[2][2], B1[2][2];
    const char* cA = (const char*)g.A + (size_t)cur.pm * tstep; const char* cB = (const char*)g.Bt + (size_t)cur.pn * tstep;
    S.a_ready(cur);
    if constexpr (SP2) {
        PG8_STAGE(PG8_SB(0, 0), cB, voffB); PG8_STAGE(PG8_SB(0, 1), cB + hstep, voffB); PG8_STAGE(PG8_SA(0, 0), cA, voffA); PG8_STAGE(PG8_SA(0, 1), cA + hstep, voffA);
        if (wr == 1) PG8_BAR;
        PG8_WAIT_V(2); PG8_BAR;
        PG8_STAGE(PG8_SB(1, 0), cB + kstep, voffB); PG8_STAGE(PG8_SA(1, 0), cA + kstep, voffA); PG8_STAGE(PG8_SB(1, 1), cB + hstep + kstep, voffB);
        PG8_WAIT_V(6); PG8_BAR;
    } else {
        PG8_STAGE(PG8_SB(0, 0), cB, voffB); PG8_STAGE(PG8_SA(0, 0), cA, voffA); PG8_STAGE(PG8_SB(0, 1), cB + hstep, voffB); PG8_STAGE(PG8_SA(0, 1), cA + hstep, voffA);
        if (wr == 1) PG8_BAR;
        PG8_WAIT_V(4); PG8_BAR;
        PG8_STAGE(PG8_SB(1, 0), cB + kstep, voffB); PG8_STAGE(PG8_SA(1, 0), cA + kstep, voffA); PG8_STAGE(PG8_SB(1, 1), cB + hstep + kstep, voffB);
        PG8_WAIT_V(6); PG8_BAR;
    }
    for (;;) {
        const bool has_next = S.next(ui + 1, nxt);
        const char* nA = has_next ? (const char*)g.A + (size_t)nxt.pm * tstep : cA; const char* nB = has_next ? (const char*)g.Bt + (size_t)nxt.pn * tstep : cB;
        for (int t = 0; t < nt; t += 2) {
            const bool last = (t == nt - 2);
            const char* a1 = cA + (size_t)(t + 1) * kstep;
            const char* a2 = last ? nA : cA + (size_t)(t + 2) * kstep; const char* b2 = last ? nB : cB + (size_t)(t + 2) * kstep;
            const char* a3 = a2 + kstep; const char* b3 = b2 + kstep;
            if (last && has_next) S.a_ready(nxt);
            if constexpr (SP2) {
            PG8_LDB(B0, 0, 0); PG8_LDB(B1, 0, 1); PG8_SCHED; PG8_LDA(At, 0, 0); PG8_STAGE(PG8_SA(1, 1), a1 + hstep, voffA);
            PG8_WAIT_V(8); PG8_WAIT_L(0); PG8_BAR; PG8_MMA(0, 0, At, B0); PG8_MMA(0, 1, At, B1); PG8_BAR; PG8_SCHED;
            PG8_LDA(At, 0, 1); PG8_STAGE(PG8_SB(0, 0), b2, voffB); PG8_STAGE(PG8_SB(0, 1), b2 + hstep, voffB); PG8_STAGE(PG8_SA(0, 0), a2, voffA);
            PG8_WAIT_V(8); PG8_WAIT_L(0); PG8_BAR; PG8_MMA(1, 0, At, B0); PG8_MMA(1, 1, At, B1); PG8_BAR; PG8_SCHED;
            PG8_LDB(B0, 1, 0); PG8_LDB(B1, 1, 1); PG8_SCHED; PG8_LDA(At, 1, 0); PG8_STAGE(PG8_SA(0, 1), a2 + hstep, voffA);
            PG8_WAIT_V(8); PG8_WAIT_L(0); PG8_BAR; PG8_MMA(0, 0, At, B0); PG8_MMA(0, 1, At, B1); PG8_BAR; PG8_SCHED;
            PG8_LDA(At, 1, 1); PG8_STAGE(PG8_SB(1, 0), b3, voffB); PG8_STAGE(PG8_SB(1, 1), b3 + hstep, voffB); PG8_STAGE(PG8_SA(1, 0), a3, voffA);
            PG8_WAIT_V(8); PG8_WAIT_L(0); PG8_BAR; PG8_MMA(1, 0, At, B0); PG8_MMA(1, 1, At, B1); PG8_BAR; PG8_SCHED;
            } else {
            PG8_LDB(B0, 0, 0); PG8_SCHED; PG8_LDA(At, 0, 0); PG8_STAGE(PG8_SA(1, 1), a1 + hstep, voffA);
            PG8_WAIT_L(8); PG8_BAR; PG8_WAIT_L(0); PG8_MMA(0, 0, At, B0); PG8_BAR; PG8_SCHED;
            PG8_LDB(B1, 0, 1); PG8_STAGE(PG8_SB(0, 0), b2, voffB);
            PG8_BAR; PG8_WAIT_L(0); PG8_MMA(0, 1, At, B1); PG8_BAR;
            PG8_LDA(At, 0, 1); PG8_STAGE(PG8_SA(0, 0), a2, voffA);
            PG8_BAR; PG8_WAIT_L(0); PG8_MMA(1, 0, At, B0); PG8_BAR; PG8_SCHED;
            PG8_STAGE(PG8_SB(0, 1), b2 + hstep, voffB);
            PG8_WAIT_V(6); PG8_BAR; PG8_MMA(1, 1, At, B1); PG8_BAR;
            PG8_LDB(B0, 1, 0); PG8_SCHED; PG8_LDA(At, 1, 0); PG8_STAGE(PG8_SA(0, 1), a2 + hstep, voffA);
            PG8_WAIT_L(8); PG8_BAR; PG8_WAIT_L(0); PG8_MMA(0, 0, At, B0); PG8_BAR; PG8_SCHED;
            PG8_LDB(B1, 1, 1); PG8_STAGE(PG8_SB(1, 0), b3, voffB);
            PG8_BAR; PG8_WAIT_L(0); PG8_MMA(0, 1, At, B1); PG8_BAR;
            PG8_LDA(At, 1, 1); PG8_STAGE(PG8_SA(1, 0), a3, voffA);
            PG8_BAR; PG8_WAIT_L(0); PG8_MMA(1, 0, At, B0); PG8_BAR; PG8_SCHED;
            PG8_STAGE(PG8_SB(1, 1), b3 + hstep, voffB);
            PG8_WAIT_V(6); PG8_BAR; PG8_MMA(1, 1, At, B1); PG8_BAR;
            }
        }
        if constexpr (ALIGN_EPI) { if (wr == 0) PG8_BAR; }
        if constexpr (!Epi::AFTER_DRAIN) { E(acc, cur, wr, wc, fr, fq); S.done(cur); }
        if (!has_next) break;
#pragma unroll
        for (int a = 0; a < 2; ++a)
#pragma unroll
            for (int b = 0; b < 2; ++b)
#pragma unroll
                for (int m = 0; m < 4; ++m)
#pragma unroll
                    for (int n = 0; n < 2; ++n) acc[a][b][m][n] = (f32x4){0.f, 0.f, 0.f, 0.f};
        cur = nxt; cA = nA; cB = nB; ++ui;
        if constexpr (ALIGN_EPI) { if (wr == 1) PG8_BAR; }
    }
    PG8_WAIT_V(0);
    if constexpr (!ALIGN_EPI) { if (wr == 0) PG8_BAR; }
    PG8_BAR;
    if constexpr (Epi::AFTER_DRAIN) { E.fused(acc, cur, wr, wc, fr, fq, lds, wid, lane); S.done(cur); }
#undef PG8_SA
#undef PG8_SB
#undef PG8_STAGE
#undef PG8_LDA
#undef PG8_LDB
#undef PG8_MMA
#undef PG8_WAIT_V
#undef PG8_WAIT_L
#undef PG8_BAR
#undef PG8_SCHED
}
}

namespace cg = cooperative_groups;
#define LAS __attribute__((address_space(3)))
typedef unsigned short bf16;
typedef float f32x4 __attribute__((ext_vector_type(4)));
typedef float f32x16 __attribute__((ext_vector_type(16)));
typedef short bf16x8 __attribute__((ext_vector_type(8)));
typedef short s16x4 __attribute__((ext_vector_type(4)));
typedef unsigned u32x4 __attribute__((ext_vector_type(4)));
typedef unsigned u32x2 __attribute__((ext_vector_type(2)));
using pg8::pk2; using pg8::bflo; using pg8::bfhi; using pg8::sigmoid_f;

#ifndef MK_SINGLE
#define MK_SINGLE 1
#endif

constexpr int SEQ = 16384, DM = 1024, DFF = 2816, INW = 11776, NWAVES = 8, NTH = 512;
constexpr float EPS = 1e-6f, LOG2E = 1.4426950408889634f;
constexpr int LDS_BYTES = 163840, MISC_OFF = LDS_BYTES - 256;
constexpr int CTL_ZERO_BYTES = 16384;
constexpr size_t MiB = 1u << 20;
constexpr size_t WS_WFI = 1 * MiB;
constexpr size_t WS_WFO = 12 * MiB;
constexpr size_t WS_WIN = 18 * MiB;
constexpr size_t WS_WPA = 41 * MiB;
constexpr size_t WS_WPB = 42 * MiB;
constexpr size_t WS_WO  = 44 * MiB;
constexpr size_t WS_ST  = 18 * MiB;
constexpr size_t WS_DT  = 34 * MiB;
constexpr size_t WS_LSE = 46 * MiB;
constexpr size_t WS_H   = 48 * MiB;
constexpr size_t WS_BIG = 80 * MiB;
constexpr size_t WS_ACT = WS_BIG;
constexpr size_t WS_Y   = WS_BIG + 88 * MiB;
constexpr size_t WS_QKV = WS_BIG;
constexpr size_t WS_YA  = 240 * MiB;
constexpr size_t WS_HG  = WS_BIG;
constexpr size_t WS_GA  = WS_BIG + 32 * MiB;
constexpr size_t WS_GH  = WS_BIG + 64 * MiB;
constexpr size_t WS_T   = WS_BIG + 96 * MiB;
constexpr size_t WS_YM  = WS_BIG + 128 * MiB;
constexpr size_t WS_Y2  = WS_BIG + 32 * MiB;
constexpr size_t WS_END = 256 * MiB;

__constant__ unsigned char T5BUCKET[3][129] = {
 {11,11,11,11,11,11,11,11,11,11,11,11,11,11,11,10,10,10,10,10,10,10,10,10,10,10,10,10,10,10,10,10,10,10,10,10,10,10,9,9,9,9,9,9,9,9,9,9,9,9,8,8,8,8,8,8,8,7,6,5,4,3,2,1,0,17,18,19,20,21,22,23,24,24,24,24,24,24,24,25,25,25,25,25,25,25,25,25,25,25,25,26,26,26,26,26,26,26,26,26,26,26,26,26,26,26,26,26,26,26,26,26,26,26,27,27,27,27,27,27,27,27,27,27,27,27,27,27,27},
 {13,13,13,13,13,13,13,13,13,13,13,13,13,13,13,13,13,13,13,13,13,13,13,12,12,12,12,12,12,12,12,12,12,12,12,12,12,12,12,12,12,12,11,11,11,11,11,11,11,11,11,11,10,10,10,10,10,10,9,9,9,8,8,4,0,20,24,24,25,25,25,26,26,26,26,26,26,27,27,27,27,27,27,27,27,27,27,28,28,28,28,28,28,28,28,28,28,28,28,28,28,28,28,28,28,28,29,29,29,29,29,29,29,29,29,29,29,29,29,29,29,29,29,29,29,29,29,29,29},
 {15,15,15,15,15,15,15,15,15,15,15,15,15,15,15,15,15,15,15,15,15,15,15,15,15,15,15,15,15,15,14,14,14,14,14,14,14,14,14,14,14,14,14,14,14,13,13,13,13,13,13,13,13,13,12,12,12,12,12,11,11,10,10,9,0,25,26,26,27,27,28,28,28,28,28,29,29,29,29,29,29,29,29,29,30,30,30,30,30,30,30,30,30,30,30,30,30,30,30,31,31,31,31,31,31,31,31,31,31,31,31,31,31,31,31,31,31,31,31,31,31,31,31,31,31,31,31,31,31}};

__device__ __forceinline__ float bf2f(bf16 b) { return __uint_as_float((unsigned)b << 16); }
__device__ __forceinline__ bf16 f2bf(float f) { return (bf16)(pk2(f, 0.f) & 0xffffu); }
__device__ __forceinline__ float wave_sum(float v) {
#pragma unroll
    for (int o = 1; o < 64; o <<= 1) v += __shfl_xor(v, o);
    return v;
}
__device__ __forceinline__ float ex2(float x) { return __builtin_amdgcn_exp2f(x); }
__device__ __forceinline__ float exn(float x) { return __builtin_amdgcn_exp2f(x * LOG2E); }

#define MFMA32(a, b, c) __builtin_amdgcn_mfma_f32_32x32x16_bf16((a), (b), (c), 0, 0, 0)
__device__ __forceinline__ bf16x8 frag_rm(const LAS unsigned char* X, int pitchB, int row0, int k0, int lane) {
    return *(const LAS bf16x8*)(X + (row0 + (lane & 31)) * pitchB + (k0 + 8 * (lane >> 5)) * 2);
}
typedef short v4i16_t __attribute__((ext_vector_type(4)));
__device__ __forceinline__ s16x4 tr_rd(const LAS unsigned char* p) { return __builtin_bit_cast(s16x4, __builtin_amdgcn_ds_read_tr16_b64_v4i16((LAS v4i16_t*)p)); }
__device__ __forceinline__ bf16x8 frag_tr(const LAS unsigned char* X, int pitchB, int k0, int col0, int lane) {
    const int G = lane >> 4, i = lane & 15, q = i >> 2, p = i & 3, h = G >> 1;
    const LAS unsigned char* a0 = X + (k0 + 8 * h + q) * pitchB + (col0 + 16 * (G & 1) + 4 * p) * 2;
    const s16x4 lo = tr_rd(a0), hi = tr_rd(a0 + 4 * pitchB);
    return (bf16x8){lo[0], lo[1], lo[2], lo[3], hi[0], hi[1], hi[2], hi[3]};
}
__device__ __forceinline__ bf16x8 frag_tr_perm(const LAS unsigned char* X, int pitchB, int k0, int col0, int lane) {
    const int G = lane >> 4, i = lane & 15, q = i >> 2, p = i & 3, h = G >> 1;
    const LAS unsigned char* a0 = X + (k0 + 4 * h + q) * pitchB + (col0 + 16 * (G & 1) + 4 * p) * 2;
    const s16x4 lo = tr_rd(a0), hi = tr_rd(a0 + 8 * pitchB);
    return (bf16x8){lo[0], lo[1], lo[2], lo[3], hi[0], hi[1], hi[2], hi[3]};
}
__device__ __forceinline__ int crow(int reg, int h) { return (reg & 3) + 8 * (reg >> 2) + 4 * h; }

#define XB_TMO      128
#define XB_XCNT(j)  (256  + 64 * (j))
#define XB_XSUB(j)  (1280 + 64 * (j))
#define XB_XGEN(j)  (2304 + 64 * (j))
#define XB_TOP      3328
#define XB_TOPGEN   3392
#define XCD_BAR_WORDS 3456
#define XB_SPIN_CAP (1u << 18)

__device__ __forceinline__ unsigned xb_ld(unsigned* p)              { return __hip_atomic_load(p, __ATOMIC_RELAXED, __HIP_MEMORY_SCOPE_AGENT); }
__device__ __forceinline__ unsigned xb_add(unsigned* p, unsigned v) { return __hip_atomic_fetch_add(p, v, __ATOMIC_RELAXED, __HIP_MEMORY_SCOPE_AGENT); }
__device__ __forceinline__ unsigned xb_xcc_id() { return (unsigned)__builtin_amdgcn_s_getreg((3 << 11) | 20) & 0xFu; }
#define XB_SPIN(cond, bar) do { unsigned _sp = 0; while (cond) { __builtin_amdgcn_s_sleep(1); \
    if ((++_sp & 255u) == 0u) { if (xb_ld(&(bar)[XB_TMO])) break; if (_sp > XB_SPIN_CAP) { atomicAdd(&(bar)[XB_TMO], 1u); break; } } } } while (0)

struct XcdBarrier {
    unsigned* bar; unsigned x;
    volatile LAS unsigned* st;
};

__device__ __forceinline__ XcdBarrier xcd_barrier_post(unsigned* bar, volatile LAS unsigned* st) {
    XcdBarrier b; b.bar = bar; b.x = xb_xcc_id(); b.st = st;
    if (threadIdx.x == 0) (void)xb_add(&bar[XB_XCNT(b.x)], 1u);
    return b;
}
__device__ __forceinline__ void xcd_barrier_complete(unsigned* bar, unsigned x, unsigned& nloc, unsigned& nx) {
    const unsigned G = gridDim.x * gridDim.y * gridDim.z;
    unsigned sum, cnt, mine, sp = 0u;
    for (;;) {
        sum = 0u; cnt = 0u; mine = 0u;
#pragma unroll
        for (unsigned j = 0; j < 16; ++j) { const unsigned c = xb_ld(&bar[XB_XCNT(j)]); sum += c; cnt += (c > 0u) ? 1u : 0u; mine = (j == x) ? c : mine; }
        if (sum == G) break;
        __builtin_amdgcn_s_sleep(1);
        if ((++sp & 255u) == 0u) { if (xb_ld(&bar[XB_TMO])) break; if (sp > XB_SPIN_CAP) { atomicAdd(&bar[XB_TMO], 1u); break; } }
    }
    nloc = mine > 0u ? mine : 1u; nx = cnt > 0u ? cnt : 1u;
}

__device__ __forceinline__ void xcd_barrier(const XcdBarrier& b) {
    asm volatile("s_waitcnt vmcnt(0)" ::: "memory");
    __syncthreads();
    if (threadIdx.x == 0) {
        unsigned* bar = b.bar;
        __builtin_amdgcn_s_waitcnt(0);
        unsigned nloc = b.st[0], nx = b.st[1];
        if (nloc == 0u) { xcd_barrier_complete(bar, b.x, nloc, nx); b.st[0] = nloc; b.st[1] = nx; }
        const unsigned old = xb_add(&bar[XB_XSUB(b.x)], 1u);
        const unsigned gen = old / nloc;
        if (old + 1u == (gen + 1u) * nloc) {
            __builtin_amdgcn_fence(__ATOMIC_RELEASE, "agent");
            asm volatile("s_waitcnt vmcnt(0)" ::: "memory");
            const unsigned og = xb_add(&bar[XB_TOP], 1u);
            const unsigned tg = og / nx;
            if (og + 1u == (tg + 1u) * nx) xb_add(&bar[XB_TOPGEN], 1u);
            else XB_SPIN(xb_ld(&bar[XB_TOPGEN]) == tg, bar);
            __builtin_amdgcn_fence(__ATOMIC_ACQUIRE, "agent");
            xb_add(&bar[XB_XGEN(b.x)], 1u);
            asm volatile("s_waitcnt vmcnt(0)" ::: "memory");
        } else {
            XB_SPIN(xb_ld(&bar[XB_XGEN(b.x)]) == gen, bar);
            __builtin_amdgcn_fence(__ATOMIC_ACQUIRE, "agent");
            asm volatile("s_waitcnt vmcnt(0)" ::: "memory");
        }
    }
    __syncthreads();
}

struct Frame {
    LAS unsigned char* lds;
    int tid, lane, wave, G, bid;
    const float* in[18]; float* out; unsigned char* ws;
};

struct ConvJob { const float* W; bf16* WT; int K, N, mapk, nitems; };
constexpr int CONV_SCR = 16896;
template <int NJ> __device__ __forceinline__ void conv_locate(const ConvJob (&jobs)[NJ], int it, ConvJob& J, int& k0, int& n0) {
    J = jobs[0]; bool found = false;
#pragma unroll
    for (int j = 0; j < NJ; ++j) { if (!found) { if (it < jobs[j].nitems || j == NJ - 1) { J = jobs[j]; found = true; } else it -= jobs[j].nitems; } }
    const int nblk = J.N >> 6; k0 = (it / nblk) << 6; n0 = (it % nblk) << 6;
}
template <int NJ> __device__ __forceinline__ void convert_weights(Frame& F, const ConvJob (&jobs)[NJ]) {
    LAS float* scr = (LAS float*)(F.lds + F.wave * CONV_SCR);
    const int gw = F.bid * NWAVES + F.wave, NGW = F.G * NWAVES, lane = F.lane, r = lane >> 4, c4 = lane & 15;
    int total = 0;
#pragma unroll
    for (int j = 0; j < NJ; ++j) total += jobs[j].nitems;
    int it = gw; if (it >= total) return;
    ConvJob J; int k0, n0; conv_locate<NJ>(jobs, it, J, k0, n0);
    f32x4 v[16];
    { const float* src = J.W + (size_t)(k0 + r) * J.N + n0 + 4 * c4; const size_t st = (size_t)4 * J.N;
#pragma unroll
      for (int i = 0; i < 16; ++i) v[i] = *(const f32x4*)(src + i * st); }
    for (;;) {
#pragma unroll
        for (int i = 0; i < 16; ++i) { LAS float* d = scr + (4 * i + r) * 65 + 4 * c4; d[0] = v[i].x; d[1] = v[i].y; d[2] = v[i].z; d[3] = v[i].w; }
        const ConvJob C = J; const int ck0 = k0, cn0 = n0;
        const int nit = it + NGW; const bool more = nit < total;
        if (more) { conv_locate<NJ>(jobs, nit, J, k0, n0);
            const float* src = J.W + (size_t)(k0 + r) * J.N + n0 + 4 * c4; const size_t st = (size_t)4 * J.N;
#pragma unroll
            for (int i = 0; i < 16; ++i) v[i] = *(const f32x4*)(src + i * st); }
        asm volatile("s_waitcnt lgkmcnt(0)" ::: "memory");
        const int K = C.K; int drow0 = cn0;
        if (C.mapk == 1) drow0 = (cn0 < DFF) ? 256 * (cn0 / 128) + (cn0 % 128) : 256 * ((cn0 - DFF) / 128) + 128 + ((cn0 - DFF) % 128);
        bf16* dst = C.WT + (size_t)drow0 * K + ck0 + 8 * (lane & 7);
#pragma unroll
        for (int j = 0; j < 8; ++j) { const int n = (lane >> 3) + 8 * j; const LAS float* sp = scr + (8 * (lane & 7)) * 65 + n;
            u32x4 o; o.x = pk2(sp[0 * 65], sp[1 * 65]); o.y = pk2(sp[2 * 65], sp[3 * 65]); o.z = pk2(sp[4 * 65], sp[5 * 65]); o.w = pk2(sp[6 * 65], sp[7 * 65]);
            *(u32x4*)(dst + (size_t)n * K) = o; }
        asm volatile("s_waitcnt lgkmcnt(0)" ::: "memory");
        if (!more) break;
        it = nit;
    }
}
__device__ __forceinline__ void row_pass(Frame& F, const float* base, const bf16* y, float ysc, const float* gpost, float* outx, const float* gpre, bf16* hout) {
    const int gw = F.bid * NWAVES + F.wave, NGW = F.G * NWAVES, lane = F.lane;
    f32x4 xn[4]; u32x2 yn[4];
    int m = gw;
    if (m < SEQ) { const f32x4* b4 = (const f32x4*)(base + (size_t)m * DM) + lane;
#pragma unroll
        for (int j = 0; j < 4; ++j) xn[j] = b4[64 * j];
        if (y) { const u32x2* y4 = (const u32x2*)(y + (size_t)m * DM) + lane;
#pragma unroll
            for (int j = 0; j < 4; ++j) yn[j] = y4[64 * j]; } }
    for (; m < SEQ; m += NGW) {
        f32x4 xv[4]; u32x2 yw[4];
#pragma unroll
        for (int j = 0; j < 4; ++j) { xv[j] = xn[j]; yw[j] = yn[j]; }
        const int mn = m + NGW;
        if (mn < SEQ) { const f32x4* b4 = (const f32x4*)(base + (size_t)mn * DM) + lane;
#pragma unroll
            for (int j = 0; j < 4; ++j) xn[j] = b4[64 * j];
            if (y) { const u32x2* y4 = (const u32x2*)(y + (size_t)mn * DM) + lane;
#pragma unroll
                for (int j = 0; j < 4; ++j) yn[j] = y4[64 * j]; } }
        if (y) {
            f32x4 yv[4]; float s = 0.f;
#pragma unroll
            for (int j = 0; j < 4; ++j) { yv[j] = (f32x4){bflo(yw[j].x), bfhi(yw[j].x), bflo(yw[j].y), bfhi(yw[j].y)}; s += (yv[j].x * yv[j].x + yv[j].y * yv[j].y) + (yv[j].z * yv[j].z + yv[j].w * yv[j].w); }
            const float r = ysc * __builtin_amdgcn_rsqf(wave_sum(s) * (1.0f / DM) + EPS);
#pragma unroll
            for (int j = 0; j < 4; ++j) { const f32x4 g = ((const f32x4*)gpost)[64 * j + lane]; xv[j] = xv[j] + yv[j] * g * r; }
        }
        if (outx) { f32x4* o4 = (f32x4*)(outx + (size_t)m * DM) + lane;
#pragma unroll
            for (int j = 0; j < 4; ++j) o4[64 * j] = xv[j]; }
        if (hout) {
            float s = 0.f;
#pragma unroll
            for (int j = 0; j < 4; ++j) s += (xv[j].x * xv[j].x + xv[j].y * xv[j].y) + (xv[j].z * xv[j].z + xv[j].w * xv[j].w);
            const float r = __builtin_amdgcn_rsqf(wave_sum(s) * (1.0f / DM) + EPS);
            u32x2* o8 = (u32x2*)(hout + (size_t)m * DM) + lane;
#pragma unroll
            for (int j = 0; j < 4; ++j) { const f32x4 g = ((const f32x4*)gpre)[64 * j + lane]; const f32x4 v = xv[j] * g * r; u32x2 w; w.x = pk2(v.x, v.y); w.y = pk2(v.z, v.w); o8[64 * j] = w; }
        }
    }
}

constexpr int AT_PITCH = 144;
constexpr int AT_K = 0, AT_V = 384 * AT_PITCH, AT_BIAS = 2 * 384 * AT_PITCH, AT_O = AT_BIAS + 768, AT_OW = 32 * AT_PITCH;
static_assert(AT_O + 8 * AT_OW <= LDS_BYTES - 256, "attention LDS map");
struct AttnU { int g, hh, r, a0, d, L, hb; };
__device__ __forceinline__ AttnU attn_decode(int u) {
    AttnU A; A.g = u >> 9; const int rem = u & 511; A.hh = rem >> 6; const int blk = rem & 63;
    const int dsh = 2 * A.g, tsh = 6 - dsh; A.d = 1 << dsh; A.L = SEQ >> dsh;
    A.r = blk >> tsh; A.a0 = (blk & ((1 << tsh) - 1)) * 256; A.hb = (A.g * 8 + A.hh) * SEQ; return A;
}
__device__ __forceinline__ void attn_phase(Frame& F, bf16* Qg, const bf16* Kg, const bf16* Vg, const float* relb, float* lse) {
    const int tid = F.tid, lane = F.lane, w = F.wave, c = lane & 31, h = lane >> 5;
    LAS unsigned char* Kl = F.lds + AT_K; LAS unsigned char* Vl = F.lds + AT_V; LAS float* biasL = (LAS float*)(F.lds + AT_BIAS);
    u32x4 kv[6], vv[6]; bf16x8 qn[4]; float bn = 0.f;
#define AT_LOAD(A_) do { \
        { const int sp0_ = (A_).a0 - 64 + (tid >> 3); const long off0_ = ((long)(A_).hb + (long)(A_).r * (A_).L + sp0_) * 64 + (tid & 7) * 8; const long st_ = 64 * 64; \
          _Pragma("unroll") for (int i = 0; i < 6; ++i) { const int sp = sp0_ + 64 * i; const bool ok = (sp >= 0) && (sp < (A_).L); \
            kv[i] = ok ? *(const u32x4*)(Kg + (off0_ + i * st_)) : (u32x4){0u, 0u, 0u, 0u}; vv[i] = ok ? *(const u32x4*)(Vg + (off0_ + i * st_)) : (u32x4){0u, 0u, 0u, 0u}; } } \
        { const size_t qoff = ((size_t)(A_).hb + (size_t)(A_).r * (A_).L + (A_).a0 + 32 * w + c) * 64 + 8 * h; \
          _Pragma("unroll") for (int ks = 0; ks < 4; ++ks) qn[ks] = *(const bf16x8*)(Qg + qoff + 16 * ks); } \
        if (tid < 192) { const int bi_ = min(max(tid - 32, 0), 128); const float bv_ = relb[(int)T5BUCKET[(A_).g][bi_] * 24 + (A_).g * 8 + (A_).hh] * LOG2E; bn = (tid >= 32 && tid <= 160) ? bv_ : -1e30f; } } while (0)
    int u = F.bid; if (u >= 1536) return;
    AttnU A = attn_decode(u);
    AT_LOAD(A);
    for (;;) {
#pragma unroll
        for (int i = 0; i < 6; ++i) { const int cidx = tid + NTH * i, row = cidx >> 3, part = cidx & 7;
            *(LAS u32x4*)(Kl + row * AT_PITCH + part * 16) = kv[i]; *(LAS u32x4*)(Vl + row * AT_PITCH + part * 16) = vv[i]; }
        if (tid < 192) biasL[tid] = bn;
        bf16x8 qf[4];
#pragma unroll
        for (int ks = 0; ks < 4; ++ks) qf[ks] = qn[ks];
        const AttnU C = A; const int un = u + F.G; const bool more = un < 1536;
        __syncthreads();
        if (more) { A = attn_decode(un); AT_LOAD(A); }
        const int a0 = C.a0, L = C.L;
        const int tokq = C.r + C.d * (a0 + 32 * w + c);
        const int kp0 = a0 + 32 * w - 64;
        const bool edge = (kp0 < 0) || (kp0 + 160 > L);
        int lb_ = 32 + 4 * h - c; asm volatile("" : "+v"(lb_));
        const LAS float* bl = biasL + lb_;
        float mx = -1e30f, l = 0.f;
        f32x16 o[2]; o[0] = (f32x16){}; o[1] = (f32x16){};
#pragma unroll
        for (int ti = 0; ti < 5; ++ti) {
            const int kt = (ti == 0) ? 2 : (ti == 1) ? 1 : (ti == 2) ? 3 : (ti == 3) ? 0 : 4;
            f32x16 st = (f32x16){};
#pragma unroll
            for (int ks = 0; ks < 4; ++ks) st = MFMA32(frag_rm(Kl, AT_PITCH, 32 * w + 32 * kt, 16 * ks, lane), qf[ks], st);
            float tm = -1e30f;
#pragma unroll
            for (int rg = 0; rg < 16; ++rg) {
                const int kc = 32 * kt + (rg & 3) + 8 * (rg >> 2);
                float sv = st[rg] + bl[kc];
                if (edge) { const int kp = kp0 + kc + 4 * h; if (kp < 0 || kp >= L) sv = -1e30f; }
                st[rg] = sv; tm = fmaxf(tm, sv);
            }
            tm = fmaxf(tm, __shfl_xor(tm, 32));
            const float mn = fmaxf(mx, tm), alpha = ex2(mx - mn); mx = mn;
            float ls = 0.f; u32x4 pw[2];
#pragma unroll
            for (int sh = 0; sh < 2; ++sh) {
                float p[8];
#pragma unroll
                for (int j = 0; j < 8; ++j) { p[j] = ex2(st[8 * sh + j] - mn); ls += p[j]; }
                pw[sh].x = pk2(p[0], p[1]); pw[sh].y = pk2(p[2], p[3]); pw[sh].z = pk2(p[4], p[5]); pw[sh].w = pk2(p[6], p[7]);
            }
            l = l * alpha + ls;
            if (ti > 0) {
#pragma unroll
                for (int rg = 0; rg < 16; ++rg) { o[0][rg] *= alpha; o[1][rg] *= alpha; }
            }
#pragma unroll
            for (int sh = 0; sh < 2; ++sh) {
                const bf16x8 pb = __builtin_bit_cast(bf16x8, pw[sh]);
#pragma unroll
                for (int eh = 0; eh < 2; ++eh) o[eh] = MFMA32(frag_tr_perm(Vl, AT_PITCH, 32 * w + 32 * kt + 16 * sh, 32 * eh, lane), pb, o[eh]);
            }
        }
        l += __shfl_xor(l, 32);
        const float inv = 1.0f / l;
        LAS unsigned char* Ow = F.lds + AT_O + w * AT_OW;
#pragma unroll
        for (int eh = 0; eh < 2; ++eh)
#pragma unroll
            for (int gq = 0; gq < 4; ++gq) {
                u32x2 wv; wv.x = pk2(o[eh][4 * gq + 0] * inv, o[eh][4 * gq + 1] * inv); wv.y = pk2(o[eh][4 * gq + 2] * inv, o[eh][4 * gq + 3] * inv);
                *(LAS u32x2*)(Ow + c * AT_PITCH + (32 * eh + 8 * gq + 4 * h) * 2) = wv;
            }
        asm volatile("s_waitcnt lgkmcnt(0)" ::: "memory");
#pragma unroll
        for (int i = 0; i < 4; ++i) { const int row = (lane >> 3) + 8 * i, part = lane & 7;
            const u32x4 ov = *(const LAS u32x4*)(Ow + row * AT_PITCH + part * 16);
            *(u32x4*)(Qg + ((size_t)C.hb + (size_t)C.r * L + a0 + 32 * w + row) * 64 + part * 8) = ov; }
        if (h == 0) lse[((size_t)C.g * SEQ + tokq) * 8 + C.hh] = __builtin_amdgcn_logf(l) + mx;
        __syncthreads();
        if (!more) break;
        u = un;
    }
#undef AT_LOAD
}
__device__ __forceinline__ void attn_merge(Frame& F, const bf16* Og, const float* lse, bf16* Ya) {
    const int gt = F.bid * NTH + F.tid, NGT = F.G * NTH;
    for (int idx = gt; idx < SEQ * 64; idx += NGT) {
        const int e8 = idx & 7, hh = (idx >> 3) & 7, tok = idx >> 6;
        float lw[3]; float mx = -1e30f;
#pragma unroll
        for (int g = 0; g < 3; ++g) { lw[g] = lse[((size_t)g * SEQ + tok) * 8 + hh]; mx = fmaxf(mx, lw[g]); }
        float sum = 0.f;
#pragma unroll
        for (int g = 0; g < 3; ++g) { lw[g] = ex2(lw[g] - mx); sum += lw[g]; }
        const float inv = 1.0f / sum;
        float a[8] = {0.f, 0.f, 0.f, 0.f, 0.f, 0.f, 0.f, 0.f};
#pragma unroll
        for (int g = 0; g < 3; ++g) {
            const int dsh = 2 * g, sidx = ((tok & ((1 << dsh) - 1)) << (14 - dsh)) + (tok >> dsh);
            const u32x4 v = *(const u32x4*)(Og + ((size_t)(g * 8 + hh) * SEQ + sidx) * 64 + e8 * 8); const float wg = lw[g] * inv;
            a[0] += wg * bflo(v.x); a[1] += wg * bfhi(v.x); a[2] += wg * bflo(v.y); a[3] += wg * bfhi(v.y);
            a[4] += wg * bflo(v.z); a[5] += wg * bfhi(v.z); a[6] += wg * bflo(v.w); a[7] += wg * bfhi(v.w);
        }
        u32x4 o; o.x = pk2(a[0], a[1]); o.y = pk2(a[2], a[3]); o.z = pk2(a[4], a[5]); o.w = pk2(a[6], a[7]);
        *(u32x4*)(Ya + (size_t)tok * 512 + hh * 64 + e8 * 8) = o;
    }
}

constexpr int HP = 272;
constexpr int T_Q = 0, T_LF = 64 * HP, T_QR = 2 * 64 * HP, T_KE = 3 * 64 * HP, T_V = 4 * 64 * HP, T_AM = 5 * 64 * HP, AMP = 144, T_ST = T_AM + 64 * AMP, V_REF = T_ST + 128 * HP, V_TOT = V_REF + 512, V_DEC = V_TOT + 512, H_END = V_DEC + 512;
static_assert(H_END <= LDS_BYTES - 256, "hgrn LDS map");
__device__ __forceinline__ u32x2 pack4(float a, float b, float c, float d) { u32x2 w; w.x = pk2(a, b); w.y = pk2(c, d); return w; }
template <bool OUT> __device__ __forceinline__ void hgrn_unit(Frame& F, int u, const bf16* qs, const bf16* lf, const bf16* vs, bf16* og, float* Ust, float* Dt) {
    const int tid = F.tid, lane = F.lane, w = F.wave, c31 = lane & 31, h = lane >> 5;
    const int dir = u & 1, head = (u >> 1) & 7, sc = u >> 4, colh = head * 128;
    LAS unsigned char* L = F.lds;
    LAS float* REF = (LAS float*)(L + V_REF); LAS float* TOT = (LAS float*)(L + V_TOT); LAS float* DEC = (LAS float*)(L + V_DEC);
    const int kb = w & 3, tb = w >> 2;
    const int tk = w >> 1, tvp = w & 1;
    const int tcb = w >> 2, tv = w & 3;
    const int srow = tid >> 4, spart = tid & 15;
    u32x4 rq[2], rl[2], rv[2];
#define HG_LOAD(ci_) do { const int p0_ = sc * 1024 + (ci_) * 64; _Pragma("unroll") for (int i = 0; i < 2; ++i) { const int p_ = p0_ + srow + 32 * i, t_ = dir ? (SEQ - 1 - p_) : p_; const size_t off_ = ((size_t)head * SEQ + t_) * 128 + spart * 8; \
        rl[i] = *(const u32x4*)(lf + off_); rv[i] = *(const u32x4*)(vs + off_); if (OUT) rq[i] = *(const u32x4*)(qs + off_); } } while (0)
#define HG_ST_LQ() do { _Pragma("unroll") for (int i = 0; i < 2; ++i) { *(LAS u32x4*)(L + T_LF + (srow + 32 * i) * HP + spart * 16) = rl[i]; if (OUT) *(LAS u32x4*)(L + T_Q + (srow + 32 * i) * HP + spart * 16) = rq[i]; } } while (0)
#define HG_ST_V() do { _Pragma("unroll") for (int i = 0; i < 2; ++i) *(LAS u32x4*)(L + T_V + (srow + 32 * i) * HP + spart * 16) = rv[i]; } while (0)
    HG_LOAD(0);
    f32x16 accS[2]; accS[0] = (f32x16){}; accS[1] = (f32x16){};
    if (OUT) {
        for (int j = 0; j < sc; ++j) {
            const int uj = ((j * 8 + head) << 1) | dir;
            const float* Ub = Ust + (size_t)uj * 16384 + (32 * tk + 4 * h) * 128 + 64 * tvp + c31; const float* Db = Dt + (size_t)uj * 128 + 32 * tk + 4 * h;
            asm volatile("" : "+v"(Ub), "+v"(Db));
#pragma unroll
            for (int n = 0; n < 2; ++n)
#pragma unroll
                for (int rg = 0; rg < 16; ++rg) { const int ko = (rg & 3) + 8 * (rg >> 2); accS[n][rg] = accS[n][rg] * Db[ko] + Ub[ko * 128 + 32 * n]; }
        }
#pragma unroll
        for (int n = 0; n < 2; ++n)
#pragma unroll
            for (int gq = 0; gq < 4; ++gq)
                *(LAS u32x2*)(L + T_ST + (32 * (2 * tvp + n) + c31) * HP + (32 * tk + 8 * gq + 4 * h) * 2) = pack4(accS[n][4 * gq], accS[n][4 * gq + 1], accS[n][4 * gq + 2], accS[n][4 * gq + 3]);
    }
    HG_ST_LQ(); HG_ST_V();
    __syncthreads();
    float stot[16];
#pragma unroll
    for (int rg = 0; rg < 16; ++rg) stot[rg] = 0.f;
    const int tpos = 32 * tb + c31;
    for (int ci = 0; ci < 16; ++ci) {
        const int p0 = sc * 1024 + ci * 64;
        if (ci + 1 < 16) HG_LOAD(ci + 1);
        f32x16 bacc = (f32x16){};
#pragma unroll
        for (int ks = 0; ks < 4; ++ks) {
            if (ks < 2 || tb == 1) {
                bf16x8 msk;
#pragma unroll
                for (int j = 0; j < 8; ++j) msk[j] = (16 * ks + 8 * h + j <= tpos) ? (short)0x3F80 : (short)0;
                bacc = MFMA32(frag_tr(L + T_LF, HP, 16 * ks, 32 * kb, lane), msk, bacc);
            }
        }
        if (tb == 1) {
            if (OUT && c31 == 0) {
#pragma unroll
                for (int rg = 0; rg < 16; ++rg) REF[32 * kb + crow(rg, h)] = bacc[rg];
            }
            if (c31 == 31) {
#pragma unroll
                for (int rg = 0; rg < 16; ++rg) { const int k = 32 * kb + crow(rg, h); TOT[k] = bacc[rg]; DEC[k] = exn(bacc[rg]); if (!OUT) stot[rg] += bacc[rg]; }
            }
        }
        __syncthreads();
#pragma unroll
        for (int g = 0; g < 4; ++g) {
            const int k4 = 32 * kb + 8 * g + 4 * h, toff = tpos * HP + k4 * 2;
            const u32x2 lw = *(const LAS u32x2*)(L + T_LF + toff);
            const f32x4 tot4 = *(const LAS f32x4*)(TOT + k4);
            const float lfv[4] = {bflo(lw.x), bfhi(lw.x), bflo(lw.y), bfhi(lw.y)};
            float kk[4], ke[4];
#pragma unroll
            for (int i = 0; i < 4; ++i) { kk[i] = 1.0f - exn(lfv[i]); ke[i] = kk[i] * exn(tot4[i] - bacc[4 * g + i]); }
            *(LAS u32x2*)(L + T_KE + toff) = pack4(ke[0], ke[1], ke[2], ke[3]);
            if (OUT) {
                const u32x2 qw = *(const LAS u32x2*)(L + T_Q + toff);
                const f32x4 ref4 = *(const LAS f32x4*)(REF + k4);
                const float qv[4] = {bflo(qw.x), bfhi(qw.x), bflo(qw.y), bfhi(qw.y)};
                float qd[4], kd[4], qr[4];
#pragma unroll
                for (int i = 0; i < 4; ++i) { const float bb = bacc[4 * g + i]; const float x = fminf(fmaxf(bb - ref4[i], -80.f), 80.f);
                    qd[i] = qv[i] * exn(x); kd[i] = kk[i] * exn(-x); qr[i] = qv[i] * exn(bb); }
                *(LAS u32x2*)(L + T_Q + toff) = pack4(qd[0], qd[1], qd[2], qd[3]);
                *(LAS u32x2*)(L + T_LF + toff) = pack4(kd[0], kd[1], kd[2], kd[3]);
                *(LAS u32x2*)(L + T_QR + toff) = pack4(qr[0], qr[1], qr[2], qr[3]);
            }
        }
        __syncthreads();
        f32x16 acco = (f32x16){};
        if (OUT) {
#pragma unroll
            for (int ks = 0; ks < 8; ++ks) acco = MFMA32(frag_rm(L + T_QR, HP, 32 * tcb, 16 * ks, lane), frag_rm(L + T_ST, HP, 32 * tv, 16 * ks, lane), acco);
            if (w < 3) {
                const int ts = (w == 2) ? 1 : 0, tc = (w >= 1) ? 1 : 0; f32x16 aa = (f32x16){};
#pragma unroll
                for (int ks = 0; ks < 8; ++ks) aa = MFMA32(frag_rm(L + T_LF, HP, 32 * ts, 16 * ks, lane), frag_rm(L + T_Q, HP, 32 * tc, 16 * ks, lane), aa);
                const int cc = 32 * tc + c31;
#pragma unroll
                for (int gq = 0; gq < 4; ++gq) { float v4[4];
#pragma unroll
                    for (int i = 0; i < 4; ++i) { const int s = 32 * ts + 8 * gq + 4 * h + i; v4[i] = (s <= cc) ? aa[4 * gq + i] : 0.f; }
                    *(LAS u32x2*)(L + T_AM + cc * AMP + (32 * ts + 8 * gq + 4 * h) * 2) = pack4(v4[0], v4[1], v4[2], v4[3]); }
            }
            __syncthreads();
        }
        if (ci + 1 < 16) HG_ST_LQ();
        if (OUT) {
#pragma unroll
            for (int ks = 0; ks < 4; ++ks) if (ks < 2 || tcb == 1) acco = MFMA32(frag_rm(L + T_AM, AMP, 32 * tcb, 16 * ks, lane), frag_tr(L + T_V, HP, 16 * ks, 32 * tv, lane), acco);
        }
        {
            float dk[16];
#pragma unroll
            for (int rg = 0; rg < 16; ++rg) dk[rg] = DEC[32 * tk + crow(rg, h)];
#pragma unroll
            for (int n = 0; n < 2; ++n) {
#pragma unroll
                for (int rg = 0; rg < 16; ++rg) accS[n][rg] *= dk[rg];
#pragma unroll
                for (int ks = 0; ks < 4; ++ks) accS[n] = MFMA32(frag_tr(L + T_KE, HP, 16 * ks, 32 * tk, lane), frag_tr(L + T_V, HP, 16 * ks, 32 * (2 * tvp + n), lane), accS[n]);
            }
        }
        if (OUT) {
#pragma unroll
            for (int n = 0; n < 2; ++n)
#pragma unroll
                for (int gq = 0; gq < 4; ++gq)
                    *(LAS u32x2*)(L + T_ST + (32 * (2 * tvp + n) + c31) * HP + (32 * tk + 8 * gq + 4 * h) * 2) = pack4(accS[n][4 * gq], accS[n][4 * gq + 1], accS[n][4 * gq + 2], accS[n][4 * gq + 3]);
#pragma unroll
            for (int rg = 0; rg < 16; ++rg) *(LAS bf16*)(L + T_QR + (32 * tcb + crow(rg, h)) * HP + (32 * tv + c31) * 2) = f2bf(acco[rg]);
        }
        __syncthreads();
        if (ci + 1 < 16) HG_ST_V();
        if (OUT) {
#pragma unroll
            for (int i = 0; i < 2; ++i) { const int p = p0 + srow + 32 * i, t = dir ? (SEQ - 1 - p) : p;
                *(u32x4*)(og + ((size_t)head * SEQ + t) * 128 + spart * 8) = *(const LAS u32x4*)(L + T_QR + (srow + 32 * i) * HP + spart * 16); }
        }
    }
    if (!OUT) {
        float* Uu = Ust + (size_t)u * 16384;
#pragma unroll
        for (int n = 0; n < 2; ++n)
#pragma unroll
            for (int rg = 0; rg < 16; ++rg) Uu[(32 * tk + crow(rg, h)) * 128 + 32 * (2 * tvp + n) + c31] = accS[n][rg];
        if (tb == 1 && c31 == 31) {
#pragma unroll
            for (int rg = 0; rg < 16; ++rg) Dt[(size_t)u * 128 + 32 * kb + crow(rg, h)] = exn(stot[rg]);
        }
    }
    __syncthreads();
#undef HG_LOAD
#undef HG_ST_LQ
#undef HG_ST_V
}
__device__ __forceinline__ void hgrn_combine(Frame& F, const bf16* of, const bf16* ob, const bf16* gs, const float* nw, bf16* yh) {
    const int gt = F.bid * NTH + F.tid, NGT = F.G * NTH;
    for (int idx = gt; idx < SEQ * 128; idx += NGT) {
        const int part = idx & 15, head = (idx >> 4) & 7, tok = idx >> 7; const size_t off = (size_t)tok * 1024 + head * 128 + part * 8, offh = ((size_t)head * SEQ + tok) * 128 + part * 8;
        const u32x4 a = *(const u32x4*)(of + offh), b = *(const u32x4*)(ob + offh), gg = *(const u32x4*)(gs + offh);
        float o[8] = {bflo(a.x) + bflo(b.x), bfhi(a.x) + bfhi(b.x), bflo(a.y) + bflo(b.y), bfhi(a.y) + bfhi(b.y), bflo(a.z) + bflo(b.z), bfhi(a.z) + bfhi(b.z), bflo(a.w) + bflo(b.w), bfhi(a.w) + bfhi(b.w)};
        float ss = 0.f;
#pragma unroll
        for (int i = 0; i < 8; ++i) ss += o[i] * o[i];
        ss += __shfl_xor(ss, 1); ss += __shfl_xor(ss, 2); ss += __shfl_xor(ss, 4); ss += __shfl_xor(ss, 8);
        const float r = __builtin_amdgcn_rsqf(ss * (1.0f / 128.0f) + EPS);
        const float gv[8] = {bflo(gg.x), bfhi(gg.x), bflo(gg.y), bfhi(gg.y), bflo(gg.z), bfhi(gg.z), bflo(gg.w), bfhi(gg.w)};
        const f32x4 n0 = *(const f32x4*)(nw + part * 8), n1 = *(const f32x4*)(nw + part * 8 + 4);
        const float nv[8] = {n0.x, n0.y, n0.z, n0.w, n1.x, n1.y, n1.z, n1.w};
#pragma unroll
        for (int i = 0; i < 8; ++i) o[i] = o[i] * r * nv[i] * gv[i];
        u32x4 wv; wv.x = pk2(o[0], o[1]); wv.y = pk2(o[2], o[3]); wv.z = pk2(o[4], o[5]); wv.w = pk2(o[6], o[7]);
        *(u32x4*)(yh + off) = wv;
    }
}

struct Params { const float* in[18]; float* out; unsigned char* ws; int ph_lo, ph_hi; };
constexpr int NPHASE = 17;
__global__ void __launch_bounds__(NTH, 2) mk_fwd(Params P) {
    extern __shared__ __attribute__((aligned(16))) unsigned char lds_raw[];
    Frame F;
    F.lds = (LAS unsigned char*)lds_raw;
    F.tid = threadIdx.x; F.lane = F.tid & 63; F.wave = __builtin_amdgcn_readfirstlane(F.tid >> 6); F.G = gridDim.x; F.bid = blockIdx.x;
#pragma unroll
    for (int i = 0; i < 18; ++i) F.in[i] = P.in[i];
    F.out = P.out; F.ws = P.ws;
    unsigned char* ws = P.ws;
    bf16* WFI = (bf16*)(ws + WS_WFI); bf16* WFO = (bf16*)(ws + WS_WFO); bf16* WIN = (bf16*)(ws + WS_WIN); bf16* WPA = (bf16*)(ws + WS_WPA); bf16* WPB = (bf16*)(ws + WS_WPB); bf16* WO = (bf16*)(ws + WS_WO);
    bf16* Hb = (bf16*)(ws + WS_H); bf16* ACT = (bf16*)(ws + WS_ACT); bf16* Yf = (bf16*)(ws + WS_Y); bf16* QKV = (bf16*)(ws + WS_QKV); bf16* YA = (bf16*)(ws + WS_YA);
    bf16* HG = (bf16*)(ws + WS_HG); float* LSE = (float*)(ws + WS_LSE); float* UST = (float*)(ws + WS_ST); float* DT = (float*)(ws + WS_DT);
    bf16* GA = (bf16*)(ws + WS_GA); bf16* GH = (bf16*)(ws + WS_GH); bf16* TT = (bf16*)(ws + WS_T); bf16* YM = (bf16*)(ws + WS_YM); bf16* Y2 = (bf16*)(ws + WS_Y2);
    const size_t SEC = (size_t)SEQ * 1024;
    const int lo = P.ph_lo, hi = P.ph_hi;
#if MK_SINGLE
    if (F.tid < 64) ((LAS unsigned*)(F.lds + MISC_OFF))[F.tid] = 0u;
    __syncthreads();
    XcdBarrier bar = xcd_barrier_post((unsigned*)ws, (volatile LAS unsigned*)(F.lds + MISC_OFF));
#define SEAM(k) do { if (lo <= (k) && (k) + 1 < hi) xcd_barrier(bar); } while (0)
#else
#define SEAM(k) do { } while (0)
#endif
#define IN(k) (lo <= (k) && (k) < hi)
#ifndef MK_DOUBLE
#define MK_DOUBLE 0
#endif
#define REPS(k) ((((MK_DOUBLE) >> (k)) & 1) ? 2 : 1)
#define REP_BEGIN(k) for (int rep_ = 0; rep_ < REPS(k); ++rep_) {
#if MK_SINGLE
#define REP_END(k) if (rep_ + 1 < REPS(k)) xcd_barrier(bar); }
#else
#define REP_END(k) }
#endif

    if (IN(0)) { REP_BEGIN(0)
        { const ConvJob jobs[6] = {{F.in[2], WFI, DM, 2 * DFF, 1, (DM / 64) * (2 * DFF / 64)}, {F.in[3], WFO, DFF, DM, 0, (DFF / 64) * (DM / 64)}, {F.in[6], WIN, DM, INW, 0, (DM / 64) * (INW / 64)},
                                    {F.in[10], WPA, 512, DM, 0, (512 / 64) * (DM / 64)}, {F.in[11], WPB, DM, DM, 0, (DM / 64) * (DM / 64)}, {F.in[12], WO, DM, DM, 0, (DM / 64) * (DM / 64)}};
          convert_weights<6>(F, jobs); }
        row_pass(F, F.in[0], nullptr, 0.f, nullptr, nullptr, F.in[1], Hb);
        __syncthreads();
        REP_END(0) SEAM(0);
    }
    if (IN(1)) { REP_BEGIN(1)
        pg8::Gemm g{Hb, WFI, SEQ, 2 * DFF, DM}; pg8::StaticOrder S; S.init(SEQ, 2 * DFF, F.G, F.bid);
        pg8::EpiSwiglu E{ACT, DFF};
        pg8::gemm_phase<pg8::EpiSwiglu, pg8::StaticOrder, true, true>(F.lds, g, S, E);
        REP_END(1) SEAM(1);
    }
    if (IN(2)) { REP_BEGIN(2)
        pg8::Gemm g{ACT, WFO, SEQ, DM, DFF}; pg8::StaticOrder S; S.init(SEQ, DM, F.G, F.bid);
        pg8::EpiSect<3> E{Yf, 1024, 0, 1.f, nullptr};
        pg8::gemm_phase<pg8::EpiSect<3>, pg8::StaticOrder, true, true>(F.lds, g, S, E);
        REP_END(2) SEAM(2);
    }
    if (IN(3)) { REP_BEGIN(3)
        row_pass(F, F.in[0], Yf, 0.5f, F.in[4], F.out, F.in[5], Hb);
        { const ConvJob jobs[2] = {{F.in[15], WFI, DM, 2 * DFF, 1, (DM / 64) * (2 * DFF / 64)}, {F.in[16], WFO, DFF, DM, 0, (DFF / 64) * (DM / 64)}};
          convert_weights<2>(F, jobs); }
        __syncthreads();
        REP_END(3) SEAM(3);
    }
    if (IN(4)) { REP_BEGIN(4)
        pg8::Gemm g{Hb, WIN, SEQ, 4608, DM}; pg8::StaticOrder S; S.init(SEQ, 4608, F.G, F.bid);
        pg8::EpiSect<0> E{QKV, 1536, (size_t)SEQ * 1536, 0.125f * LOG2E, nullptr};
        pg8::gemm_phase<pg8::EpiSect<0>, pg8::StaticOrder, true, true>(F.lds, g, S, E);
        REP_END(4) SEAM(4);
    }
    if (IN(5)) {
        attn_phase(F, QKV, QKV + (size_t)SEQ * 1536, QKV + (size_t)2 * SEQ * 1536, F.in[7], LSE);
        SEAM(5);
    }
    if (IN(6)) { REP_BEGIN(6) attn_merge(F, QKV, LSE, YA); REP_END(6) SEAM(6); }
    if (IN(7)) { REP_BEGIN(7)
        pg8::Gemm g{Hb, WIN + (size_t)4608 * DM, SEQ, 5120, DM}; pg8::StaticOrder S; S.init(SEQ, 5120, F.G, F.bid);
        pg8::EpiSect<1> E{HG, 1024, SEC, 1.f, F.in[8]};
        pg8::gemm_phase<pg8::EpiSect<1>, pg8::StaticOrder, true, true>(F.lds, g, S, E);
        REP_END(7) SEAM(7);
    }
    if (IN(8)) { REP_BEGIN(8)
        for (int u = F.bid; u < 256; u += F.G) hgrn_unit<false>(F, u, HG, HG + ((u & 1) ? 2 : 1) * SEC, HG + 3 * SEC, nullptr, UST, DT);
        REP_END(8) SEAM(8);
    }
    if (IN(9)) {
        for (int u = F.bid; u < 256; u += F.G) { bf16* lfp = HG + ((u & 1) ? 2 : 1) * SEC; hgrn_unit<true>(F, u, HG, lfp, HG + 3 * SEC, lfp, UST, DT); }
        SEAM(9);
    }
    if (IN(10)) { REP_BEGIN(10) hgrn_combine(F, HG + SEC, HG + 2 * SEC, HG + 4 * SEC, F.in[9], HG); REP_END(10) SEAM(10); }
    if (IN(11)) { REP_BEGIN(11)
        pg8::StaticOrder S; S.init(SEQ, DM, F.G, F.bid);
        { pg8::Gemm g{Hb, WIN + (size_t)9728 * DM, SEQ, DM, DM}; pg8::EpiSect<2> E{GA, 1024, 0, 1.f, nullptr}; pg8::gemm_phase<pg8::EpiSect<2>, pg8::StaticOrder, true, true>(F.lds, g, S, E); }
        { pg8::Gemm g{YA, WPA, SEQ, DM, 512}; pg8::EpiGated<false> E{TT, GA, nullptr, DM}; pg8::gemm_phase<pg8::EpiGated<false>, pg8::StaticOrder, true, true>(F.lds, g, S, E); }
        { pg8::Gemm g{Hb, WIN + (size_t)10752 * DM, SEQ, DM, DM}; pg8::EpiSect<2> E{GH, 1024, 0, 1.f, nullptr}; pg8::gemm_phase<pg8::EpiSect<2>, pg8::StaticOrder, true, true>(F.lds, g, S, E); }
        { pg8::Gemm g{HG, WPB, SEQ, DM, DM}; pg8::EpiGated<true> E{YM, GH, TT, DM}; pg8::gemm_phase<pg8::EpiGated<true>, pg8::StaticOrder, true, true>(F.lds, g, S, E); }
        REP_END(11) SEAM(11);
    }
    if (IN(12)) { REP_BEGIN(12)
        pg8::Gemm g{YM, WO, SEQ, DM, DM}; pg8::StaticOrder S; S.init(SEQ, DM, F.G, F.bid);
        pg8::EpiSect<3> E{Y2, 1024, 0, 1.f, nullptr};
        pg8::gemm_phase<pg8::EpiSect<3>, pg8::StaticOrder, true, true>(F.lds, g, S, E);
        REP_END(12) SEAM(12);
    }
    if (IN(13)) { row_pass(F, F.out, Y2, 1.0f, F.in[13], F.out, F.in[14], Hb); SEAM(13); }
    if (IN(14)) { REP_BEGIN(14)
        pg8::Gemm g{Hb, WFI, SEQ, 2 * DFF, DM}; pg8::StaticOrder S; S.init(SEQ, 2 * DFF, F.G, F.bid);
        pg8::EpiSwiglu E{ACT, DFF};
        pg8::gemm_phase<pg8::EpiSwiglu, pg8::StaticOrder, true, true>(F.lds, g, S, E);
        REP_END(14) SEAM(14);
    }
    if (IN(15)) { REP_BEGIN(15)
        pg8::Gemm g{ACT, WFO, SEQ, DM, DFF}; pg8::StaticOrder S; S.init(SEQ, DM, F.G, F.bid);
        pg8::EpiSect<3> E{Yf, 1024, 0, 1.f, nullptr};
        pg8::gemm_phase<pg8::EpiSect<3>, pg8::StaticOrder, true, true>(F.lds, g, S, E);
        REP_END(15) SEAM(15);
    }
    if (IN(16)) { row_pass(F, F.out, Yf, 0.5f, F.in[17], F.out, nullptr, nullptr); }
#ifdef MK_EXTRA
    xcd_barrier(bar);
#if MK_EXTRA & 1
    attn_phase(F, QKV, QKV + (size_t)SEQ * 1536, QKV + (size_t)2 * SEQ * 1536, F.in[7], LSE);
    xcd_barrier(bar);
#endif
#if MK_EXTRA & 2
    for (int u = F.bid; u < 256; u += F.G) hgrn_unit<false>(F, u, HG, HG + ((u & 1) ? 2 : 1) * SEC, HG + 3 * SEC, nullptr, UST, DT);
    xcd_barrier(bar);
#endif
#if MK_EXTRA & 4
    for (int u = F.bid; u < 256; u += F.G) { bf16* lfp = HG + ((u & 1) ? 2 : 1) * SEC; hgrn_unit<true>(F, u, HG, lfp, HG + 3 * SEC, lfp, UST, DT); }
    xcd_barrier(bar);
#endif
#if MK_EXTRA & 8
    attn_merge(F, QKV, LSE, YA); xcd_barrier(bar);
    hgrn_combine(F, HG + SEC, HG + 2 * SEC, HG + 4 * SEC, F.in[9], HG); xcd_barrier(bar);
#endif
#if MK_EXTRA & 16
    xcd_barrier(bar);
#endif
#if MK_EXTRA & 32
    row_pass(F, F.in[0], Yf, 0.5f, F.in[4], (float*)(ws + WS_BIG), F.in[5], Hb); xcd_barrier(bar);
#endif
#endif
#undef IN
#undef SEAM
}

extern "C" void kernel_launch(void* const* d_in, const int* in_sizes, int n_in, void* d_out, int out_size, void* d_ws, size_t ws_size, hipStream_t stream) {
    static int grid = 0;
    if (grid == 0) {
        if (n_in != 18 || out_size != SEQ * DM || ws_size < WS_END) { fprintf(stderr, "kernel_launch: unexpected shapes (n_in %d out %d ws %zu)\n", n_in, out_size, ws_size); grid = -1; return; }
        int dev = 0, cus = 0, per_cu = 0;
        if (hipGetDevice(&dev) != hipSuccess || hipDeviceGetAttribute(&cus, hipDeviceAttributeMultiprocessorCount, dev) != hipSuccess) { grid = -1; return; }
        if (hipFuncSetAttribute((const void*)mk_fwd, hipFuncAttributeMaxDynamicSharedMemorySize, LDS_BYTES) != hipSuccess) { fprintf(stderr, "kernel_launch: hipFuncSetAttribute failed\n"); grid = -1; return; }
        if (hipOccupancyMaxActiveBlocksPerMultiprocessor(&per_cu, (const void*)mk_fwd, NTH, LDS_BYTES) != hipSuccess || per_cu < 1) { fprintf(stderr, "kernel_launch: occupancy query says %d\n", per_cu); per_cu = 1; }
        (void)hipGetLastError();
        grid = cus;
    }
    if (grid < 0) return;
    Params p{};
    for (int i = 0; i < 18; ++i) p.in[i] = (const float*)d_in[i];
    p.out = (float*)d_out; p.ws = (unsigned char*)d_ws;
#if MK_SINGLE
    p.ph_lo = 0; p.ph_hi = NPHASE;
    if (hipMemsetAsync(d_ws, 0, CTL_ZERO_BYTES, stream) != hipSuccess) { fprintf(stderr, "kernel_launch: memset failed\n"); return; }
    void* args[] = {&p};
    hipError_t e = hipLaunchCooperativeKernel((const void*)mk_fwd, dim3(grid), dim3(NTH), args, LDS_BYTES, stream);
    if (e != hipSuccess) fprintf(stderr, "cooperative launch failed: %s (grid %d)\n", hipGetErrorString(e), grid);
#else
    for (int ph = 0; ph < NPHASE; ++ph) { p.ph_lo = ph; p.ph_hi = ph + 1; hipLaunchKernelGGL(mk_fwd, dim3(grid), dim3(NTH), LDS_BYTES, stream, p); }
#endif
}
```

```cpp
#include <hip/hip_runtime.h>
#include <hip/hip_cooperative_groups.h>
#include <cstdio>
#include <cstdint>
namespace pg8 {
#define PG8_LAS __attribute__((address_space(3)))
typedef unsigned short bf16_t;
typedef short bf16x8 __attribute__((ext_vector_type(8)));
typedef float f32x4 __attribute__((ext_vector_type(4)));
typedef unsigned u32x4 __attribute__((ext_vector_type(4)));
constexpr int BM = 256, BK = 64, HALF = 128, HTB = HALF * BK * 2  , STAGE_BYTES = 8 * HTB, NXCD = 8, WGM = 8;

__host__ __device__ __forceinline__ int lds_byte(int r, int c) { const int st = (r >> 4) * 2 + (c >> 5), rr = r & 15, cc = c & 31, ob = rr * 64 + cc * 2; return st * 1024 + (ob ^ (((ob >> 9) & 1) << 5)); }
__host__ __device__ __forceinline__ void stage_rc(int b, int& R, int& C) { const int st = b / 1024, sb = b % 1024, swz = sb ^ (((sb >> 9) & 1) << 5); R = (st >> 1) * 16 + swz / 64; C = (st & 1) * 32 + (swz % 64) / 2; }
__host__ __device__ __forceinline__ int perm32(int rho) { const int n = rho >> 4, i = rho & 15; return 8 * (i >> 2) + 4 * n + (i & 3); }

struct Unit { int pm, pn; };
struct Gemm { const bf16_t* A; const bf16_t* Bt; int M, N, K; };

struct StaticOrder {
    int nM, nN, nwg, G, c;
    __host__ __device__ void init(int M, int N, int G_, int c_) { nM = M / BM; nN = N / BM; nwg = nM * nN; G = G_; c = c_; }
    __host__ __device__ bool next(int i, Unit& u) const {
        const long L = (long)i * G + c; if (L >= nwg) return false;
        int wgid = (int)L; { const int q = nwg / NXCD, r = nwg % NXCD, xcd = wgid % NXCD, off = wgid / NXCD; wgid = (xcd < r ? xcd * (q + 1) : r * (q + 1) + (xcd - r) * q) + off; }
        const int nig = WGM * nN, gid = wgid / nig, fm = gid * WGM, gsz = (nM - fm) < WGM ? (nM - fm) : WGM;
        u.pm = fm + ((wgid % nig) % gsz); u.pn = (wgid % nig) / gsz; return true;
    }
    __device__ __forceinline__ void a_ready(const Unit&) const {}
    __device__ __forceinline__ void done(const Unit&) const {}
};

__device__ __forceinline__ unsigned cvt_pk_bf16(float lo, float hi) { unsigned r; asm volatile("v_cvt_pk_bf16_f32 %0, %1, %2" : "=v"(r) : "v"(lo), "v"(hi)); return r; }
typedef float f32x2 __attribute__((ext_vector_type(2)));
typedef __bf16 bf16x2v __attribute__((ext_vector_type(2)));
__device__ __forceinline__ unsigned pk2(float lo, float hi) { f32x2 v = {lo, hi}; bf16x2v b = __builtin_convertvector(v, bf16x2v); return __builtin_bit_cast(unsigned, b); }
__device__ __forceinline__ float bflo(unsigned w) { return __uint_as_float(w << 16); }
__device__ __forceinline__ float bfhi(unsigned w) { return __uint_as_float(w & 0xffff0000u); }
__device__ __forceinline__ float sigmoid_f(float x) { return __builtin_amdgcn_rcpf(1.0f + __builtin_amdgcn_exp2f(-1.4426950408889634f * x)); }
__device__ __forceinline__ float silu_f(float x) { return x * sigmoid_f(x); }
__device__ __forceinline__ u32x4 pack8(const f32x4& a, const f32x4& b) { u32x4 w; w.x = pk2(a[0], a[1]); w.y = pk2(a[2], a[3]); w.z = pk2(b[0], b[1]); w.w = pk2(b[2], b[3]); return w; }

struct EpiSwiglu {
    static constexpr bool PERM = true, AFTER_DRAIN = false;
    bf16_t* O; int ldc;
    __device__ __forceinline__ void operator()(const f32x4 (&acc)[2][2][4][2], const Unit& u, int wr, int wc, int fr, int fq) const {
        const int row0 = u.pm * BM + wr * 64 + fr, col0 = u.pn * HALF + wc * 32 + 8 * fq;
#pragma unroll
        for (int ai = 0; ai < 2; ++ai)
#pragma unroll
            for (int m = 0; m < 4; ++m) {
                bf16_t* rowp = O + (size_t)(row0 + ai * HALF + m * 16) * ldc + col0;
                f32x4 r0, r1;
#pragma unroll
                for (int i = 0; i < 4; ++i) { r0[i] = silu_f(acc[ai][0][m][0][i]) * acc[ai][1][m][0][i]; r1[i] = silu_f(acc[ai][0][m][1][i]) * acc[ai][1][m][1][i]; }
                *(u32x4*)rowp = pack8(r0, r1);
            }
    }
};
struct EpiF32 {
    static constexpr bool PERM = false, AFTER_DRAIN = false;
    float* O; int ldc;
    __device__ __forceinline__ void operator()(const f32x4 (&acc)[2][2][4][2], const Unit& u, int wr, int wc, int fr, int fq) const {
        const int row0 = u.pm * BM + wr * 64 + fr, col0 = u.pn * BM + wc * 32 + 4 * fq;
#pragma unroll
        for (int ai = 0; ai < 2; ++ai)
#pragma unroll
            for (int m = 0; m < 4; ++m) {
                float* rowp = O + (size_t)(row0 + ai * HALF + m * 16) * ldc + col0;
#pragma unroll
                for (int bj = 0; bj < 2; ++bj)
#pragma unroll
                    for (int n = 0; n < 2; ++n) *(f32x4*)(rowp + bj * HALF + n * 16) = acc[ai][bj][m][n];
            }
    }
};
template <int MODE> struct EpiSect {
    static constexpr bool PERM = true, AFTER_DRAIN = false;
    bf16_t* O; int sec_cols; size_t sec_stride; float scale0; const float* lbraw;
    __device__ __forceinline__ void operator()(const f32x4 (&acc)[2][2][4][2], const Unit& u, int wr, int wc, int fr, int fq) const {
        const int row0 = u.pm * BM + wr * 64 + fr; const int colt = u.pn * BM; const int sec = colt / sec_cols; const int ch0 = colt - sec * sec_cols + wc * 32 + 8 * fq;
        bf16_t* base = O + (size_t)sec * sec_stride;
        int grp = 0, hbase = 0, cin = ch0;
        if (MODE == 0) { grp = ch0 >> 9; hbase = (ch0 >> 6) & 7; cin = ch0 & 63; }
        if (MODE == 1) { hbase = ch0 >> 7; cin = ch0 & 127; }
        float lb[2][8];
        if (MODE == 1 && (sec == 1 || sec == 2)) {
#pragma unroll
            for (int bj = 0; bj < 2; ++bj)
#pragma unroll
                for (int i = 0; i < 8; ++i) { const int ch = ch0 + bj * HALF + i; lb[bj][i] = sigmoid_f(lbraw[(sec - 1) * 2048 + ch] - lbraw[(sec - 1) * 2048 + 1024 + ch]); }
        }
#pragma unroll
        for (int ai = 0; ai < 2; ++ai)
#pragma unroll
            for (int m = 0; m < 4; ++m) {
                const int row = row0 + ai * HALF + m * 16;
                bf16_t* rowp = base + (size_t)row * sec_cols + ch0; size_t bjstep = HALF;
                if (MODE == 0) { const int dsh = 2 * grp, sidx = ((row & ((1 << dsh) - 1)) << (14 - dsh)) + (row >> dsh);
                    rowp = base + ((size_t)((grp * 8 + hbase) * 16384 + sidx) << 6) + cin; bjstep = (size_t)2 * 16384 * 64; }
                if (MODE == 1) { rowp = base + ((size_t)(hbase * 16384 + row) << 7) + cin; bjstep = (size_t)16384 * 128; }
#pragma unroll
                for (int bj = 0; bj < 2; ++bj) {
                    f32x4 v0 = acc[ai][bj][m][0], v1 = acc[ai][bj][m][1];
                    if (MODE == 0) { if (sec == 0) { v0 = v0 * scale0; v1 = v1 * scale0; } }
                    else if (MODE == 3) { }
                    else if (MODE == 2) {
#pragma unroll
                        for (int i = 0; i < 4; ++i) { v0[i] = sigmoid_f(v0[i]); v1[i] = sigmoid_f(v1[i]); }
                    } else {
                        if (sec == 0 || sec == 4) {
#pragma unroll
                            for (int i = 0; i < 4; ++i) { v0[i] = silu_f(v0[i]); v1[i] = silu_f(v1[i]); }
                        } else if (sec == 1 || sec == 2) {
#pragma unroll
                            for (int i = 0; i < 4; ++i) {
                                v0[i] = log1pf(-(1.0f - lb[bj][i]) * sigmoid_f(-v0[i])); v1[i] = log1pf(-(1.0f - lb[bj][4 + i]) * sigmoid_f(-v1[i])); }
                        }
                    }
                    *(u32x4*)(rowp + bj * bjstep) = pack8(v0, v1);
                }
            }
    }
};
template <bool ADD> struct EpiGated {
    static constexpr bool PERM = true, AFTER_DRAIN = false;
    bf16_t* O; const bf16_t* G; const bf16_t* T; int ldc;
    __device__ __forceinline__ void operator()(const f32x4 (&acc)[2][2][4][2], const Unit& u, int wr, int wc, int fr, int fq) const {
        const int row0 = u.pm * BM + wr * 64 + fr, col0 = u.pn * BM + wc * 32 + 8 * fq;
#pragma unroll
        for (int ai = 0; ai < 2; ++ai)
#pragma unroll
            for (int m = 0; m < 4; ++m) {
                const size_t off = (size_t)(row0 + ai * HALF + m * 16) * ldc + col0;
#pragma unroll
                for (int bj = 0; bj < 2; ++bj) {
                    const u32x4 gw = *(const u32x4*)(G + off + bj * HALF);
                    f32x4 v0 = acc[ai][bj][m][0], v1 = acc[ai][bj][m][1];
                    v0[0] *= bflo(gw.x); v0[1] *= bfhi(gw.x); v0[2] *= bflo(gw.y); v0[3] *= bfhi(gw.y);
                    v1[0] *= bflo(gw.z); v1[1] *= bfhi(gw.z); v1[2] *= bflo(gw.w); v1[3] *= bfhi(gw.w);
                    if (ADD) { const u32x4 tw = *(const u32x4*)(T + off + bj * HALF);
                        v0[0] += bflo(tw.x); v0[1] += bfhi(tw.x); v0[2] += bflo(tw.y); v0[3] += bfhi(tw.y);
                        v1[0] += bflo(tw.z); v1[1] += bfhi(tw.z); v1[2] += bflo(tw.w); v1[3] += bfhi(tw.w); }
                    *(u32x4*)(O + off + bj * HALF) = pack8(v0, v1);
                }
            }
    }
};
template <class Epi, class Sched, bool ALIGN_EPI = false, bool SP2 = false>
__device__ __forceinline__ void gemm_phase(PG8_LAS unsigned char* lds, const Gemm g, const Sched& S, const Epi& E) {
    const int tid = threadIdx.x, wid = __builtin_amdgcn_readfirstlane(tid >> 6), lane = tid & 63, wr = wid >> 2, wc = wid & 3, fr = lane & 15, fq = lane >> 4;
    const int K = g.K, nt = K / BK;
    unsigned voffA[2], voffB[2];
#pragma unroll
    for (int i = 0; i < 2; ++i) { int R, C; stage_rc(tid * 16 + i * 8192, R, C); const int Rb = Epi::PERM ? ((R & ~31) + perm32(R & 31)) : R;
        voffA[i] = (unsigned)(R * K + C) * 2u; voffB[i] = (unsigned)(Rb * K + C) * 2u; }
    const size_t kstep = (size_t)(BK * 2);
    const size_t hstep = (size_t)HALF * K * 2;
    const size_t tstep = 2 * hstep;
    const unsigned ldsw = (unsigned)wid * 1024u;
    const int aoff = lds_byte(wr * 64 + fr, fq * 8), boff = lds_byte(wc * 32 + fr, fq * 8);
#define PG8_SA(b, h) (((b) * 2 + (h)) * HTB)
#define PG8_SB(b, h) ((4 + (b) * 2 + (h)) * HTB)
#define PG8_STAGE(bufoff, gbase, voff) do { _Pragma("unroll") for (int _i = 0; _i < 2; ++_i) \
        __builtin_amdgcn_global_load_lds((const unsigned*)((const char*)(gbase) + (voff)[_i]), (PG8_LAS unsigned*)(lds + (bufoff) + ldsw + _i * 8192), 16, 0, 0); } while (0)
#define PG8_LDA(dst, b, h) do { _Pragma("unroll") for (int m = 0; m < 4; ++m) _Pragma("unroll") for (int k = 0; k < 2; ++k) dst[m][k] = *(const PG8_LAS bf16x8*)(lds + PG8_SA(b, h) + aoff + m * 2048 + k * 1024); } while (0)
#define PG8_LDB(dst, b, h) do { _Pragma("unroll") for (int n = 0; n < 2; ++n) _Pragma("unroll") for (int k = 0; k < 2; ++k) dst[n][k] = *(const PG8_LAS bf16x8*)(lds + PG8_SB(b, h) + boff + n * 2048 + k * 1024); } while (0)
#define PG8_MMA(ai, bj, At, Bt) do { __builtin_amdgcn_s_setprio(1); _Pragma("unroll") for (int m = 0; m < 4; ++m) _Pragma("unroll") for (int n = 0; n < 2; ++n) _Pragma("unroll") for (int k = 0; k < 2; ++k) \
        acc[ai][bj][m][n] = __builtin_amdgcn_mfma_f32_16x16x32_bf16(Bt[n][k], At[m][k], acc[ai][bj][m][n], 0, 0, 0); __builtin_amdgcn_s_setprio(0); } while (0)
#define PG8_WAIT_V(n) asm volatile("s_waitcnt vmcnt(" #n ")" ::: "memory")
#define PG8_WAIT_L(n) asm volatile("s_waitcnt lgkmcnt(" #n ")" ::: "memory")
#define PG8_BAR __builtin_amdgcn_s_barrier()
#define PG8_SCHED __builtin_amdgcn_sched_barrier(0)
    Unit cur, nxt; int ui = 0;
    if (!S.next(0, cur)) return;
    f32x4 acc[2][2][4][2];
#pragma unroll
    for (int a = 0; a < 2; ++a)
#pragma unroll
        for (int b = 0; b < 2; ++b)
#pragma unroll
            for (int m = 0; m < 4; ++m)
#pragma unroll
                for (int n = 0; n < 2; ++n) acc[a][b][m][n] = (f32x4){0.f, 0.f, 0.f, 0.f};
    bf16x8 At[4][2], B0[2][2], B1[2][2];
    const char* cA = (const char*)g.A + (size_t)cur.pm * tstep; const char* cB = (const char*)g.Bt + (size_t)cur.pn * tstep;
    S.a_ready(cur);
    if constexpr (SP2) {
        PG8_STAGE(PG8_SB(0, 0), cB, voffB); PG8_STAGE(PG8_SB(0, 1), cB + hstep, voffB); PG8_STAGE(PG8_SA(0, 0), cA, voffA); PG8_STAGE(PG8_SA(0, 1), cA + hstep, voffA);
        if (wr == 1) PG8_BAR;
        PG8_WAIT_V(2); PG8_BAR;
        PG8_STAGE(PG8_SB(1, 0), cB + kstep, voffB); PG8_STAGE(PG8_SA(1, 0), cA + kstep, voffA); PG8_STAGE(PG8_SB(1, 1), cB + hstep + kstep, voffB);
        PG8_WAIT_V(6); PG8_BAR;
    } else {
        PG8_STAGE(PG8_SB(0, 0), cB, voffB); PG8_STAGE(PG8_SA(0, 0), cA, voffA); PG8_STAGE(PG8_SB(0, 1), cB + hstep, voffB); PG8_STAGE(PG8_SA(0, 1), cA + hstep, voffA);
        if (wr == 1) PG8_BAR;
        PG8_WAIT_V(4); PG8_BAR;
        PG8_STAGE(PG8_SB(1, 0), cB + kstep, voffB); PG8_STAGE(PG8_SA(1, 0), cA + kstep, voffA); PG8_STAGE(PG8_SB(1, 1), cB + hstep + kstep, voffB);
        PG8_WAIT_V(6); PG8_BAR;
    }
    for (;;) {
        const bool has_next = S.next(ui + 1, nxt);
        const char* nA = has_next ? (const char*)g.A + (size_t)nxt.pm * tstep : cA; const char* nB = has_next ? (const char*)g.Bt + (size_t)nxt.pn * tstep : cB;
        for (int t = 0; t < nt; t += 2) {
            const bool last = (t == nt - 2);
            const char* a1 = cA + (size_t)(t + 1) * kstep;
            const char* a2 = last ? nA : cA + (size_t)(t + 2) * kstep; const char* b2 = last ? nB : cB + (size_t)(t + 2) * kstep;
            const char* a3 = a2 + kstep; const char* b3 = b2 + kstep;
            if (last && has_next) S.a_ready(nxt);
            if constexpr (SP2) {
            PG8_LDB(B0, 0, 0); PG8_LDB(B1, 0, 1); PG8_SCHED; PG8_LDA(At, 0, 0); PG8_STAGE(PG8_SA(1, 1), a1 + hstep, voffA);
            PG8_WAIT_V(8); PG8_WAIT_L(0); PG8_BAR; PG8_MMA(0, 0, At, B0); PG8_MMA(0, 1, At, B1); PG8_BAR; PG8_SCHED;
            PG8_LDA(At, 0, 1); PG8_STAGE(PG8_SB(0, 0), b2, voffB); PG8_STAGE(PG8_SB(0, 1), b2 + hstep, voffB); PG8_STAGE(PG8_SA(0, 0), a2, voffA);
            PG8_WAIT_V(8); PG8_WAIT_L(0); PG8_BAR; PG8_MMA(1, 0, At, B0); PG8_MMA(1, 1, At, B1); PG8_BAR; PG8_SCHED;
            PG8_LDB(B0, 1, 0); PG8_LDB(B1, 1, 1); PG8_SCHED; PG8_LDA(At, 1, 0); PG8_STAGE(PG8_SA(0, 1), a2 + hstep, voffA);
            PG8_WAIT_V(8); PG8_WAIT_L(0); PG8_BAR; PG8_MMA(0, 0, At, B0); PG8_MMA(0, 1, At, B1); PG8_BAR; PG8_SCHED;
            PG8_LDA(At, 1, 1); PG8_STAGE(PG8_SB(1, 0), b3, voffB); PG8_STAGE(PG8_SB(1, 1), b3 + hstep, voffB); PG8_STAGE(PG8_SA(1, 0), a3, voffA);
            PG8_WAIT_V(8); PG8_WAIT_L(0); PG8_BAR; PG8_MMA(1, 0, At, B0); PG8_MMA(1, 1, At, B1); PG8_BAR; PG8_SCHED;
            } else {
            PG8_LDB(B0, 0, 0); PG8_SCHED; PG8_LDA(At, 0, 0); PG8_STAGE(PG8_SA(1, 1), a1 + hstep, voffA);
            PG8_WAIT_L(8); PG8_BAR; PG8_WAIT_L(0); PG8_MMA(0, 0, At, B0); PG8_BAR; PG8_SCHED;
            PG8_LDB(B1, 0, 1); PG8_STAGE(PG8_SB(0, 0), b2, voffB);
            PG8_BAR; PG8_WAIT_L(0); PG8_MMA(0, 1, At, B1); PG8_BAR;
            PG8_LDA(At, 0, 1); PG8_STAGE(PG8_SA(0, 0), a2, voffA);
            PG8_BAR; PG8_WAIT_L(0); PG8_MMA(1, 0, At, B0); PG8_BAR; PG8_SCHED;
            PG8_STAGE(PG8_SB(0, 1), b2 + hstep, voffB);
            PG8_WAIT_V(6); PG8_BAR; PG8_MMA(1, 1, At, B1); PG8_BAR;
            PG8_LDB(B0, 1, 0); PG8_SCHED; PG8_LDA(At, 1, 0); PG8_STAGE(PG8_SA(0, 1), a2 + hstep, voffA);
            PG8_WAIT_L(8); PG8_BAR; PG8_WAIT_L(0); PG8_MMA(0, 0, At, B0); PG8_BAR; PG8_SCHED;
            PG8_LDB(B1, 1, 1); PG8_STAGE(PG8_SB(1, 0), b3, voffB);
            PG8_BAR; PG8_WAIT_L(0); PG8_MMA(0, 1, At, B1); PG8_BAR;
            PG8_LDA(At, 1, 1); PG8_STAGE(PG8_SA(1, 0), a3, voffA);
            PG8_BAR; PG8_WAIT_L(0); PG8_MMA(1, 0, At, B0); PG8_BAR; PG8_SCHED;
            PG8_STAGE(PG8_SB(1, 1), b3 + hstep, voffB);
            PG8_WAIT_V(6); PG8_BAR; PG8_MMA(1, 1, At, B1); PG8_BAR;
            }
        }
        if constexpr (ALIGN_EPI) { if (wr == 0) PG8_BAR; }
        if constexpr (!Epi::AFTER_DRAIN) { E(acc, cur, wr, wc, fr, fq); S.done(cur); }
        if (!has_next) break;
#pragma unroll
        for (int a = 0; a < 2; ++a)
#pragma unroll
            for (int b = 0; b < 2; ++b)
#pragma unroll
                for (int m = 0; m < 4; ++m)
#pragma unroll
                    for (int n = 0; n < 2; ++n) acc[a][b][m][n] = (f32x4){0.f, 0.f, 0.f, 0.f};
        cur = nxt; cA = nA; cB = nB; ++ui;
        if constexpr (ALIGN_EPI) { if (wr == 1) PG8_BAR; }
    }
    PG8_WAIT_V(0);
    if constexpr (!ALIGN_EPI) { if (wr == 0) PG8_BAR; }
    PG8_BAR;
    if constexpr (Epi::AFTER_DRAIN) { E.fused(acc, cur, wr, wc, fr, fq, lds, wid, lane); S.done(cur); }
#undef PG8_SA
#undef PG8_SB
#undef PG8_STAGE
#undef PG8_LDA
#undef PG8_LDB
#undef PG8_MMA
#undef PG8_WAIT_V
#undef PG8_WAIT_L
#undef PG8_BAR
#undef PG8_SCHED
}
}

namespace cg = cooperative_groups;
#define LAS __attribute__((address_space(3)))
typedef unsigned short bf16;
typedef float f32x4 __attribute__((ext_vector_type(4)));
typedef float f32x16 __attribute__((ext_vector_type(16)));
typedef short bf16x8 __attribute__((ext_vector_type(8)));
typedef short s16x4 __attribute__((ext_vector_type(4)));
typedef unsigned u32x4 __attribute__((ext_vector_type(4)));
typedef unsigned u32x2 __attribute__((ext_vector_type(2)));
using pg8::pk2; using pg8::bflo; using pg8::bfhi; using pg8::sigmoid_f;

#ifndef MK_SINGLE
#define MK_SINGLE 1
#endif

constexpr int SEQ = 16384, DM = 1024, DFF = 2816, INW = 11776, NWAVES = 8, NTH = 512;
constexpr float EPS = 1e-6f, LOG2E = 1.4426950408889634f;
constexpr int LDS_BYTES = 163840, MISC_OFF = LDS_BYTES - 256;
constexpr int CTL_ZERO_BYTES = 16384;
constexpr size_t MiB = 1u << 20;
constexpr size_t WS_WFI = 1 * MiB;
constexpr size_t WS_WFO = 12 * MiB;
constexpr size_t WS_WIN = 18 * MiB;
constexpr size_t WS_WPA = 41 * MiB;
constexpr size_t WS_WPB = 42 * MiB;
constexpr size_t WS_WO  = 44 * MiB;
constexpr size_t WS_ST  = 18 * MiB;
constexpr size_t WS_DT  = 34 * MiB;
constexpr size_t WS_LSE = 46 * MiB;
constexpr size_t WS_H   = 48 * MiB;
constexpr size_t WS_BIG = 80 * MiB;
constexpr size_t WS_ACT = WS_BIG;
constexpr size_t WS_Y   = WS_BIG + 88 * MiB;
constexpr size_t WS_QKV = WS_BIG;
constexpr size_t WS_YA  = 240 * MiB;
constexpr size_t WS_HG  = WS_BIG;
constexpr size_t WS_GA  = WS_BIG + 32 * MiB;
constexpr size_t WS_GH  = WS_BIG + 64 * MiB;
constexpr size_t WS_T   = WS_BIG + 96 * MiB;
constexpr size_t WS_YM  = WS_BIG + 128 * MiB;
constexpr size_t WS_Y2  = WS_BIG + 32 * MiB;
constexpr size_t WS_END = 256 * MiB;

__constant__ unsigned char T5BUCKET[3][129] = {
 {11,11,11,11,11,11,11,11,11,11,11,11,11,11,11,10,10,10,10,10,10,10,10,10,10,10,10,10,10,10,10,10,10,10,10,10,10,10,9,9,9,9,9,9,9,9,9,9,9,9,8,8,8,8,8,8,8,7,6,5,4,3,2,1,0,17,18,19,20,21,22,23,24,24,24,24,24,24,24,25,25,25,25,25,25,25,25,25,25,25,25,26,26,26,26,26,26,26,26,26,26,26,26,26,26,26,26,26,26,26,26,26,26,26,27,27,27,27,27,27,27,27,27,27,27,27,27,27,27},
 {13,13,13,13,13,13,13,13,13,13,13,13,13,13,13,13,13,13,13,13,13,13,13,12,12,12,12,12,12,12,12,12,12,12,12,12,12,12,12,12,12,12,11,11,11,11,11,11,11,11,11,11,10,10,10,10,10,10,9,9,9,8,8,4,0,20,24,24,25,25,25,26,26,26,26,26,26,27,27,27,27,27,27,27,27,27,27,28,28,28,28,28,28,28,28,28,28,28,28,28,28,28,28,28,28,28,29,29,29,29,29,29,29,29,29,29,29,29,29,29,29,29,29,29,29,29,29,29,29},
 {15,15,15,15,15,15,15,15,15,15,15,15,15,15,15,15,15,15,15,15,15,15,15,15,15,15,15,15,15,15,14,14,14,14,14,14,14,14,14,14,14,14,14,14,14,13,13,13,13,13,13,13,13,13,12,12,12,12,12,11,11,10,10,9,0,25,26,26,27,27,28,28,28,28,28,29,29,29,29,29,29,29,29,29,30,30,30,30,30,30,30,30,30,30,30,30,30,30,30,31,31,31,31,31,31,31,31,31,31,31,31,31,31,31,31,31,31,31,31,31,31,31,31,31,31,31,31,31,31}};

__device__ __forceinline__ float bf2f(bf16 b) { return __uint_as_float((unsigned)b << 16); }
__device__ __forceinline__ bf16 f2bf(float f) { return (bf16)(pk2(f, 0.f) & 0xffffu); }
__device__ __forceinline__ float wave_sum(float v) {
#pragma unroll
    for (int o = 1; o < 64; o <<= 1) v += __shfl_xor(v, o);
    return v;
}
__device__ __forceinline__ float ex2(float x) { return __builtin_amdgcn_exp2f(x); }
__device__ __forceinline__ float exn(float x) { return __builtin_amdgcn_exp2f(x * LOG2E); }

#define MFMA32(a, b, c) __builtin_amdgcn_mfma_f32_32x32x16_bf16((a), (b), (c), 0, 0, 0)
__device__ __forceinline__ bf16x8 frag_rm(const LAS unsigned char* X, int pitchB, int row0, int k0, int lane) {
    return *(const LAS bf16x8*)(X + (row0 + (lane & 31)) * pitchB + (k0 + 8 * (lane >> 5)) * 2);
}
typedef short v4i16_t __attribute__((ext_vector_type(4)));
__device__ __forceinline__ s16x4 tr_rd(const LAS unsigned char* p) { return __builtin_bit_cast(s16x4, __builtin_amdgcn_ds_read_tr16_b64_v4i16((LAS v4i16_t*)p)); }
__device__ __forceinline__ bf16x8 frag_tr(const LAS unsigned char* X, int pitchB, int k0, int col0, int lane) {
    const int G = lane >> 4, i = lane & 15, q = i >> 2, p = i & 3, h = G >> 1;
    const LAS unsigned char* a0 = X + (k0 + 8 * h + q) * pitchB + (col0 + 16 * (G & 1) + 4 * p) * 2;
    const s16x4 lo = tr_rd(a0), hi = tr_rd(a0 + 4 * pitchB);
    return (bf16x8){lo[0], lo[1], lo[2], lo[3], hi[0], hi[1], hi[2], hi[3]};
}
__device__ __forceinline__ bf16x8 frag_tr_perm(const LAS unsigned char* X, int pitchB, int k0, int col0, int lane) {
    const int G = lane >> 4, i = lane & 15, q = i >> 2, p = i & 3, h = G >> 1;
    const LAS unsigned char* a0 = X + (k0 + 4 * h + q) * pitchB + (col0 + 16 * (G & 1) + 4 * p) * 2;
    const s16x4 lo = tr_rd(a0), hi = tr_rd(a0 + 8 * pitchB);
    return (bf16x8){lo[0], lo[1], lo[2], lo[3], hi[0], hi[1], hi[2], hi[3]};
}
__device__ __forceinline__ int crow(int reg, int h) { return (reg & 3) + 8 * (reg >> 2) + 4 * h; }

#define XB_TMO      128
#define XB_XCNT(j)  (256  + 64 * (j))
#define XB_XSUB(j)  (1280 + 64 * (j))
#define XB_XGEN(j)  (2304 + 64 * (j))
#define XB_TOP      3328
#define XB_TOPGEN   3392
#define XCD_BAR_WORDS 3456
#define XB_SPIN_CAP (1u << 18)

__device__ __forceinline__ unsigned xb_ld(unsigned* p)              { return __hip_atomic_load(p, __ATOMIC_RELAXED, __HIP_MEMORY_SCOPE_AGENT); }
__device__ __forceinline__ unsigned xb_add(unsigned* p, unsigned v) { return __hip_atomic_fetch_add(p, v, __ATOMIC_RELAXED, __HIP_MEMORY_SCOPE_AGENT); }
__device__ __forceinline__ unsigned xb_xcc_id() { return (unsigned)__builtin_amdgcn_s_getreg((3 << 11) | 20) & 0xFu; }
#define XB_SPIN(cond, bar) do { unsigned _sp = 0; while (cond) { __builtin_amdgcn_s_sleep(1); \
    if ((++_sp & 255u) == 0u) { if (xb_ld(&(bar)[XB_TMO])) break; if (_sp > XB_SPIN_CAP) { atomicAdd(&(bar)[XB_TMO], 1u); break; } } } } while (0)

struct XcdBarrier {
    unsigned* bar; unsigned x;
    volatile LAS unsigned* st;
};

__device__ __forceinline__ XcdBarrier xcd_barrier_post(unsigned* bar, volatile LAS unsigned* st) {
    XcdBarrier b; b.bar = bar; b.x = xb_xcc_id(); b.st = st;
    if (threadIdx.x == 0) (void)xb_add(&bar[XB_XCNT(b.x)], 1u);
    return b;
}
__device__ __forceinline__ void xcd_barrier_complete(unsigned* bar, unsigned x, unsigned& nloc, unsigned& nx) {
    const unsigned G = gridDim.x * gridDim.y * gridDim.z;
    unsigned sum, cnt, mine, sp = 0u;
    for (;;) {
        sum = 0u; cnt = 0u; mine = 0u;
#pragma unroll
        for (unsigned j = 0; j < 16; ++j) { const unsigned c = xb_ld(&bar[XB_XCNT(j)]); sum += c; cnt += (c > 0u) ? 1u : 0u; mine = (j == x) ? c : mine; }
        if (sum == G) break;
        __builtin_amdgcn_s_sleep(1);
        if ((++sp & 255u) == 0u) { if (xb_ld(&bar[XB_TMO])) break; if (sp > XB_SPIN_CAP) { atomicAdd(&bar[XB_TMO], 1u); break; } }
    }
    nloc = mine > 0u ? mine : 1u; nx = cnt > 0u ? cnt : 1u;
}

__device__ __forceinline__ void xcd_barrier(const XcdBarrier& b) {
    asm volatile("s_waitcnt vmcnt(0)" ::: "memory");
    __syncthreads();
    if (threadIdx.x == 0) {
        unsigned* bar = b.bar;
        __builtin_amdgcn_s_waitcnt(0);
        unsigned nloc = b.st[0], nx = b.st[1];
        if (nloc == 0u) { xcd_barrier_complete(bar, b.x, nloc, nx); b.st[0] = nloc; b.st[1] = nx; }
        const unsigned old = xb_add(&bar[XB_XSUB(b.x)], 1u);
        const unsigned gen = old / nloc;
        if (old + 1u == (gen + 1u) * nloc) {
            __builtin_amdgcn_fence(__ATOMIC_RELEASE, "agent");
            asm volatile("s_waitcnt vmcnt(0)" ::: "memory");
            const unsigned og = xb_add(&bar[XB_TOP], 1u);
            const unsigned tg = og / nx;
            if (og + 1u == (tg + 1u) * nx) xb_add(&bar[XB_TOPGEN], 1u);
            else XB_SPIN(xb_ld(&bar[XB_TOPGEN]) == tg, bar);
            __builtin_amdgcn_fence(__ATOMIC_ACQUIRE, "agent");
            xb_add(&bar[XB_XGEN(b.x)], 1u);
            asm volatile("s_waitcnt vmcnt(0)" ::: "memory");
        } else {
            XB_SPIN(xb_ld(&bar[XB_XGEN(b.x)]) == gen, bar);
            __builtin_amdgcn_fence(__ATOMIC_ACQUIRE, "agent");
            asm volatile("s_waitcnt vmcnt(0)" ::: "memory");
        }
    }
    __syncthreads();
}

struct Frame {
    LAS unsigned char* lds;
    int tid, lane, wave, G, bid;
    const float* in[18]; float* out; unsigned char* ws;
};

struct ConvJob { const float* W; bf16* WT; int K, N, mapk, nitems; };
constexpr int CONV_SCR = 16896;
template <int NJ> __device__ __forceinline__ void conv_locate(const ConvJob (&jobs)[NJ], int it, ConvJob& J, int& k0, int& n0) {
    J = jobs[0]; bool found = false;
#pragma unroll
    for (int j = 0; j < NJ; ++j) { if (!found) { if (it < jobs[j].nitems || j == NJ - 1) { J = jobs[j]; found = true; } else it -= jobs[j].nitems; } }
    const int nblk = J.N >> 6; k0 = (it / nblk) << 6; n0 = (it % nblk) << 6;
}
template <int NJ> __device__ __forceinline__ void convert_weights(Frame& F, const ConvJob (&jobs)[NJ]) {
    LAS float* scr = (LAS float*)(F.lds + F.wave * CONV_SCR);
    const int gw = F.bid * NWAVES + F.wave, NGW = F.G * NWAVES, lane = F.lane, r = lane >> 4, c4 = lane & 15;
    int total = 0;
#pragma unroll
    for (int j = 0; j < NJ; ++j) total += jobs[j].nitems;
    int it = gw; if (it >= total) return;
    ConvJob J; int k0, n0; conv_locate<NJ>(jobs, it, J, k0, n0);
    f32x4 v[16];
    { const float* src = J.W + (size_t)(k0 + r) * J.N + n0 + 4 * c4; const size_t st = (size_t)4 * J.N;
#pragma unroll
      for (int i = 0; i < 16; ++i) v[i] = *(const f32x4*)(src + i * st); }
    for (;;) {
#pragma unroll
        for (int i = 0; i < 16; ++i) { LAS float* d = scr + (4 * i + r) * 65 + 4 * c4; d[0] = v[i].x; d[1] = v[i].y; d[2] = v[i].z; d[3] = v[i].w; }
        const ConvJob C = J; const int ck0 = k0, cn0 = n0;
        const int nit = it + NGW; const bool more = nit < total;
        if (more) { conv_locate<NJ>(jobs, nit, J, k0, n0);
            const float* src = J.W + (size_t)(k0 + r) * J.N + n0 + 4 * c4; const size_t st = (size_t)4 * J.N;
#pragma unroll
            for (int i = 0; i < 16; ++i) v[i] = *(const f32x4*)(src + i * st); }
        asm volatile("s_waitcnt lgkmcnt(0)" ::: "memory");
        const int K = C.K; int drow0 = cn0;
        if (C.mapk == 1) drow0 = (cn0 < DFF) ? 256 * (cn0 / 128) + (cn0 % 128) : 256 * ((cn0 - DFF) / 128) + 128 + ((cn0 - DFF) % 128);
        bf16* dst = C.WT + (size_t)drow0 * K + ck0 + 8 * (lane & 7);
#pragma unroll
        for (int j = 0; j < 8; ++j) { const int n = (lane >> 3) + 8 * j; const LAS float* sp = scr + (8 * (lane & 7)) * 65 + n;
            u32x4 o; o.x = pk2(sp[0 * 65], sp[1 * 65]); o.y = pk2(sp[2 * 65], sp[3 * 65]); o.z = pk2(sp[4 * 65], sp[5 * 65]); o.w = pk2(sp[6 * 65], sp[7 * 65]);
            *(u32x4*)(dst + (size_t)n * K) = o; }
        asm volatile("s_waitcnt lgkmcnt(0)" ::: "memory");
        if (!more) break;
        it = nit;
    }
}
__device__ __forceinline__ void row_pass(Frame& F, const float* base, const bf16* y, float ysc, const float* gpost, float* outx, const float* gpre, bf16* hout) {
    const int gw = F.bid * NWAVES + F.wave, NGW = F.G * NWAVES, lane = F.lane;
    f32x4 xn[4]; u32x2 yn[4];
    int m = gw;
    if (m < SEQ) { const f32x4* b4 = (const f32x4*)(base + (size_t)m * DM) + lane;
#pragma unroll
        for (int j = 0; j < 4; ++j) xn[j] = b4[64 * j];
        if (y) { const u32x2* y4 = (const u32x2*)(y + (size_t)m * DM) + lane;
#pragma unroll
            for (int j = 0; j < 4; ++j) yn[j] = y4[64 * j]; } }
    for (; m < SEQ; m += NGW) {
        f32x4 xv[4]; u32x2 yw[4];
#pragma unroll
        for (int j = 0; j < 4; ++j) { xv[j] = xn[j]; yw[j] = yn[j]; }
        const int mn = m + NGW;
        if (mn < SEQ) { const f32x4* b4 = (const f32x4*)(base + (size_t)mn * DM) + lane;
#pragma unroll
            for (int j = 0; j < 4; ++j) xn[j] = b4[64 * j];
            if (y) { const u32x2* y4 = (const u32x2*)(y + (size_t)mn * DM) + lane;
#pragma unroll
                for (int j = 0; j < 4; ++j) yn[j] = y4[64 * j]; } }
        if (y) {
            f32x4 yv[4]; float s = 0.f;
#pragma unroll
            for (int j = 0; j < 4; ++j) { yv[j] = (f32x4){bflo(yw[j].x), bfhi(yw[j].x), bflo(yw[j].y), bfhi(yw[j].y)}; s += (yv[j].x * yv[j].x + yv[j].y * yv[j].y) + (yv[j].z * yv[j].z + yv[j].w * yv[j].w); }
            const float r = ysc * __builtin_amdgcn_rsqf(wave_sum(s) * (1.0f / DM) + EPS);
#pragma unroll
            for (int j = 0; j < 4; ++j) { const f32x4 g = ((const f32x4*)gpost)[64 * j + lane]; xv[j] = xv[j] + yv[j] * g * r; }
        }
        if (outx) { f32x4* o4 = (f32x4*)(outx + (size_t)m * DM) + lane;
#pragma unroll
            for (int j = 0; j < 4; ++j) o4[64 * j] = xv[j]; }
        if (hout) {
            float s = 0.f;
#pragma unroll
            for (int j = 0; j < 4; ++j) s += (xv[j].x * xv[j].x + xv[j].y * xv[j].y) + (xv[j].z * xv[j].z + xv[j].w * xv[j].w);
            const float r = __builtin_amdgcn_rsqf(wave_sum(s) * (1.0f / DM) + EPS);
            u32x2* o8 = (u32x2*)(hout + (size_t)m * DM) + lane;
#pragma unroll
            for (int j = 0; j < 4; ++j) { const f32x4 g = ((const f32x4*)gpre)[64 * j + lane]; const f32x4 v = xv[j] * g * r; u32x2 w; w.x = pk2(v.x, v.y); w.y = pk2(v.z, v.w); o8[64 * j] = w; }
        }
    }
}

constexpr int AT_PITCH = 144;
constexpr int AT_K = 0, AT_V = 384 * AT_PITCH, AT_BIAS = 2 * 384 * AT_PITCH, AT_O = AT_BIAS + 768, AT_OW = 32 * AT_PITCH;
static_assert(AT_O + 8 * AT_OW <= LDS_BYTES - 256, "attention LDS map");
struct AttnU { int g, hh, r, a0, d, L, hb; };
__device__ __forceinline__ AttnU attn_decode(int u) {
    AttnU A; A.g = u >> 9; const int rem = u & 511; A.hh = rem >> 6; const int blk = rem & 63;
    const int dsh = 2 * A.g, tsh = 6 - dsh; A.d = 1 << dsh; A.L = SEQ >> dsh;
    A.r = blk >> tsh; A.a0 = (blk & ((1 << tsh) - 1)) * 256; A.hb = (A.g * 8 + A.hh) * SEQ; return A;
}
template <bool STORE> __device__ __forceinline__ void attn_phase(Frame& F, bf16* Qg, const bf16* Kg, const bf16* Vg, const float* relb, float* lse) {
    const int tid = F.tid, lane = F.lane, w = F.wave, c = lane & 31, h = lane >> 5;
    LAS unsigned char* Kl = F.lds + AT_K; LAS unsigned char* Vl = F.lds + AT_V; LAS float* biasL = (LAS float*)(F.lds + AT_BIAS);
    u32x4 kv[6], vv[6]; bf16x8 qn[4]; float bn = 0.f;
#define AT_LOAD(A_) do { \
        { const int sp0_ = (A_).a0 - 64 + (tid >> 3); const long off0_ = ((long)(A_).hb + (long)(A_).r * (A_).L + sp0_) * 64 + (tid & 7) * 8; const long st_ = 64 * 64; \
          _Pragma("unroll") for (int i = 0; i < 6; ++i) { const int sp = sp0_ + 64 * i; const bool ok = (sp >= 0) && (sp < (A_).L); \
            kv[i] = ok ? *(const u32x4*)(Kg + (off0_ + i * st_)) : (u32x4){0u, 0u, 0u, 0u}; vv[i] = ok ? *(const u32x4*)(Vg + (off0_ + i * st_)) : (u32x4){0u, 0u, 0u, 0u}; } } \
        { const size_t qoff = ((size_t)(A_).hb + (size_t)(A_).r * (A_).L + (A_).a0 + 32 * w + c) * 64 + 8 * h; \
          _Pragma("unroll") for (int ks = 0; ks < 4; ++ks) qn[ks] = *(const bf16x8*)(Qg + qoff + 16 * ks); } \
        if (tid < 192) { const int bi_ = min(max(tid - 32, 0), 128); const float bv_ = relb[(int)T5BUCKET[(A_).g][bi_] * 24 + (A_).g * 8 + (A_).hh] * LOG2E; bn = (tid >= 32 && tid <= 160) ? bv_ : -1e30f; } } while (0)
    int u = F.bid; if (u >= 1536) return;
    AttnU A = attn_decode(u);
    AT_LOAD(A);
    for (;;) {
#pragma unroll
        for (int i = 0; i < 6; ++i) { const int cidx = tid + NTH * i, row = cidx >> 3, part = cidx & 7;
            *(LAS u32x4*)(Kl + row * AT_PITCH + part * 16) = kv[i]; *(LAS u32x4*)(Vl + row * AT_PITCH + part * 16) = vv[i]; }
        if (tid < 192) biasL[tid] = bn;
        bf16x8 qf[4];
#pragma unroll
        for (int ks = 0; ks < 4; ++ks) qf[ks] = qn[ks];
        const AttnU C = A; const int un = u + F.G; const bool more = un < 1536;
        __syncthreads();
        if (more) { A = attn_decode(un); AT_LOAD(A); }
        const int a0 = C.a0, L = C.L;
        const int tokq = C.r + C.d * (a0 + 32 * w + c);
        const int kp0 = a0 + 32 * w - 64;
        const bool edge = (kp0 < 0) || (kp0 + 160 > L);
        int lb_ = 32 + 4 * h - c; asm volatile("" : "+v"(lb_));
        const LAS float* bl = biasL + lb_;
        float mx = -1e30f, l = 0.f;
        f32x16 o[2]; o[0] = (f32x16){}; o[1] = (f32x16){};
#pragma unroll
        for (int ti = 0; ti < 5; ++ti) {
            const int kt = (ti == 0) ? 2 : (ti == 1) ? 1 : (ti == 2) ? 3 : (ti == 3) ? 0 : 4;
            f32x16 st = (f32x16){};
#pragma unroll
            for (int ks = 0; ks < 4; ++ks) st = MFMA32(frag_rm(Kl, AT_PITCH, 32 * w + 32 * kt, 16 * ks, lane), qf[ks], st);
            float tm = -1e30f;
#pragma unroll
            for (int rg = 0; rg < 16; ++rg) {
                const int kc = 32 * kt + (rg & 3) + 8 * (rg >> 2);
                float sv = st[rg] + bl[kc];
                if (edge) { const int kp = kp0 + kc + 4 * h; if (kp < 0 || kp >= L) sv = -1e30f; }
                st[rg] = sv; tm = fmaxf(tm, sv);
            }
            tm = fmaxf(tm, __shfl_xor(tm, 32));
            const float mn = fmaxf(mx, tm), alpha = ex2(mx - mn); mx = mn;
            float ls = 0.f; u32x4 pw[2];
#pragma unroll
            for (int sh = 0; sh < 2; ++sh) {
                float p[8];
#pragma unroll
                for (int j = 0; j < 8; ++j) { p[j] = ex2(st[8 * sh + j] - mn); ls += p[j]; }
                pw[sh].x = pk2(p[0], p[1]); pw[sh].y = pk2(p[2], p[3]); pw[sh].z = pk2(p[4], p[5]); pw[sh].w = pk2(p[6], p[7]);
            }
            l = l * alpha + ls;
            if (ti > 0) {
#pragma unroll
                for (int rg = 0; rg < 16; ++rg) { o[0][rg] *= alpha; o[1][rg] *= alpha; }
            }
#pragma unroll
            for (int sh = 0; sh < 2; ++sh) {
                const bf16x8 pb = __builtin_bit_cast(bf16x8, pw[sh]);
#pragma unroll
                for (int eh = 0; eh < 2; ++eh) o[eh] = MFMA32(frag_tr_perm(Vl, AT_PITCH, 32 * w + 32 * kt + 16 * sh, 32 * eh, lane), pb, o[eh]);
            }
        }
        l += __shfl_xor(l, 32);
        const float inv = 1.0f / l;
        LAS unsigned char* Ow = F.lds + AT_O + w * AT_OW;
#pragma unroll
        for (int eh = 0; eh < 2; ++eh)
#pragma unroll
            for (int gq = 0; gq < 4; ++gq) {
                u32x2 wv; wv.x = pk2(o[eh][4 * gq + 0] * inv, o[eh][4 * gq + 1] * inv); wv.y = pk2(o[eh][4 * gq + 2] * inv, o[eh][4 * gq + 3] * inv);
                *(LAS u32x2*)(Ow + c * AT_PITCH + (32 * eh + 8 * gq + 4 * h) * 2) = wv;
            }
        asm volatile("s_waitcnt lgkmcnt(0)" ::: "memory");
#pragma unroll
        for (int i = 0; i < 4; ++i) { const int row = (lane >> 3) + 8 * i, part = lane & 7;
            const u32x4 ov = *(const LAS u32x4*)(Ow + row * AT_PITCH + part * 16);
            if (STORE || ov.x == 0x12345678u) *(u32x4*)(Qg + ((size_t)C.hb + (size_t)C.r * L + a0 + 32 * w + row) * 64 + part * 8) = ov; }
        if ((STORE || l == 12345.678f) && h == 0) lse[((size_t)C.g * SEQ + tokq) * 8 + C.hh] = __builtin_amdgcn_logf(l) + mx;
        __syncthreads();
        if (!more) break;
        u = un;
    }
#undef AT_LOAD
}
__device__ __forceinline__ void attn_merge(Frame& F, const bf16* Og, const float* lse, bf16* Ya) {
    const int gt = F.bid * NTH + F.tid, NGT = F.G * NTH;
    for (int idx = gt; idx < SEQ * 64; idx += NGT) {
        const int e8 = idx & 7, hh = (idx >> 3) & 7, tok = idx >> 6;
        float lw[3]; float mx = -1e30f;
#pragma unroll
        for (int g = 0; g < 3; ++g) { lw[g] = lse[((size_t)g * SEQ + tok) * 8 + hh]; mx = fmaxf(mx, lw[g]); }
        float sum = 0.f;
#pragma unroll
        for (int g = 0; g < 3; ++g) { lw[g] = ex2(lw[g] - mx); sum += lw[g]; }
        const float inv = 1.0f / sum;
        float a[8] = {0.f, 0.f, 0.f, 0.f, 0.f, 0.f, 0.f, 0.f};
#pragma unroll
        for (int g = 0; g < 3; ++g) {
            const int dsh = 2 * g, sidx = ((tok & ((1 << dsh) - 1)) << (14 - dsh)) + (tok >> dsh);
            const u32x4 v = *(const u32x4*)(Og + ((size_t)(g * 8 + hh) * SEQ + sidx) * 64 + e8 * 8); const float wg = lw[g] * inv;
            a[0] += wg * bflo(v.x); a[1] += wg * bfhi(v.x); a[2] += wg * bflo(v.y); a[3] += wg * bfhi(v.y);
            a[4] += wg * bflo(v.z); a[5] += wg * bfhi(v.z); a[6] += wg * bflo(v.w); a[7] += wg * bfhi(v.w);
        }
        u32x4 o; o.x = pk2(a[0], a[1]); o.y = pk2(a[2], a[3]); o.z = pk2(a[4], a[5]); o.w = pk2(a[6], a[7]);
        *(u32x4*)(Ya + (size_t)tok * 512 + hh * 64 + e8 * 8) = o;
    }
}

__device__ __forceinline__ int swz(int row, int col) { return 256 * row + 16 * ((col >> 3) ^ (((row & 3) << 2) | ((row >> 2) & 3))) + (col & 7) * 2; }
__device__ __forceinline__ bf16x8 frag_rm_s(const LAS unsigned char* X, int row0, int k0, int lane) { return *(const LAS bf16x8*)(X + swz(row0 + (lane & 31), k0 + 8 * (lane >> 5))); }
__device__ __forceinline__ bf16x8 frag_tr_s(const LAS unsigned char* X, int k0, int col0, int lane) {
    const int G = lane >> 4, i = lane & 15, q = i >> 2, p = i & 3, h = G >> 1, row = k0 + 8 * h + q, col = col0 + 16 * (G & 1) + 4 * p;
    const s16x4 lo = tr_rd(X + swz(row, col)), hi = tr_rd(X + swz(row + 4, col));
    return (bf16x8){lo[0], lo[1], lo[2], lo[3], hi[0], hi[1], hi[2], hi[3]};
}
constexpr int T_Q = 0, T_LF = 16384, T_QR = 2 * 16384, T_KE = 3 * 16384, T_V = 4 * 16384, T_AM = 5 * 16384, AMP = 144, T_ST = T_AM + 64 * AMP, V_REF = T_ST + 32768, V_TOT = V_REF + 512, V_DEC = V_TOT + 512, H_END = V_DEC + 512;
static_assert(H_END <= LDS_BYTES - 256, "hgrn LDS map");
__device__ __forceinline__ u32x2 pack4(float a, float b, float c, float d) { u32x2 w; w.x = pk2(a, b); w.y = pk2(c, d); return w; }
template <bool OUT, bool STORE = true> __device__ __forceinline__ void hgrn_unit(Frame& F, int u, const bf16* qs, const bf16* lf, const bf16* vs, bf16* og, float* Ust, float* Dt) {
    const int tid = F.tid, lane = F.lane, w = F.wave, c31 = lane & 31, h = lane >> 5;
    const int dir = u & 1, head = (u >> 1) & 7, sc = u >> 4, colh = head * 128;
    LAS unsigned char* L = F.lds;
    LAS float* REF = (LAS float*)(L + V_REF); LAS float* TOT = (LAS float*)(L + V_TOT); LAS float* DEC = (LAS float*)(L + V_DEC);
    const int kb = w & 3, tb = w >> 2;
    const int tk = w >> 1, tvp = w & 1;
    const int tcb = w >> 2, tv = w & 3;
    const int srow = tid >> 4, spart = tid & 15;
    u32x4 rq[2], rl[2], rv[2];
#define HG_LOAD(ci_) do { const int p0_ = sc * 1024 + (ci_) * 64; _Pragma("unroll") for (int i = 0; i < 2; ++i) { const int p_ = p0_ + srow + 32 * i, t_ = dir ? (SEQ - 1 - p_) : p_; const size_t off_ = ((size_t)head * SEQ + t_) * 128 + spart * 8; \
        rl[i] = *(const u32x4*)(lf + off_); rv[i] = *(const u32x4*)(vs + off_); if (OUT) rq[i] = *(const u32x4*)(qs + off_); } } while (0)
#define HG_ST_LQ() do { _Pragma("unroll") for (int i = 0; i < 2; ++i) { *(LAS u32x4*)(L + T_LF + swz(srow + 32 * i, spart * 8)) = rl[i]; if (OUT) *(LAS u32x4*)(L + T_Q + swz(srow + 32 * i, spart * 8)) = rq[i]; } } while (0)
#define HG_ST_V() do { _Pragma("unroll") for (int i = 0; i < 2; ++i) *(LAS u32x4*)(L + T_V + swz(srow + 32 * i, spart * 8)) = rv[i]; } while (0)
    HG_LOAD(0);
    f32x16 accS[2]; accS[0] = (f32x16){}; accS[1] = (f32x16){};
    if (OUT) {
        for (int j = 0; j < sc; ++j) {
            const int uj = ((j * 8 + head) << 1) | dir;
            const float* Ub = Ust + (size_t)uj * 16384 + (32 * tk + 4 * h) * 128 + 64 * tvp + c31; const float* Db = Dt + (size_t)uj * 128 + 32 * tk + 4 * h;
            asm volatile("" : "+v"(Ub), "+v"(Db));
#pragma unroll
            for (int n = 0; n < 2; ++n)
#pragma unroll
                for (int rg = 0; rg < 16; ++rg) { const int ko = (rg & 3) + 8 * (rg >> 2); accS[n][rg] = accS[n][rg] * Db[ko] + Ub[ko * 128 + 32 * n]; }
        }
#pragma unroll
        for (int n = 0; n < 2; ++n)
#pragma unroll
            for (int gq = 0; gq < 4; ++gq)
                *(LAS u32x2*)(L + T_ST + swz(32 * (2 * tvp + n) + c31, 32 * tk + 8 * gq + 4 * h)) = pack4(accS[n][4 * gq], accS[n][4 * gq + 1], accS[n][4 * gq + 2], accS[n][4 * gq + 3]);
    }
    HG_ST_LQ(); HG_ST_V();
    __syncthreads();
    float stot[16];
#pragma unroll
    for (int rg = 0; rg < 16; ++rg) stot[rg] = 0.f;
    const int tpos = 32 * tb + c31;
    for (int ci = 0; ci < 16; ++ci) {
        const int p0 = sc * 1024 + ci * 64;
        if (ci + 1 < 16) HG_LOAD(ci + 1);
        f32x16 bacc = (f32x16){};
#pragma unroll
        for (int ks = 0; ks < 4; ++ks) {
            if (ks < 2 || tb == 1) {
                bf16x8 msk;
#pragma unroll
                for (int j = 0; j < 8; ++j) msk[j] = (16 * ks + 8 * h + j <= tpos) ? (short)0x3F80 : (short)0;
                bacc = MFMA32(frag_tr_s(L + T_LF, 16 * ks, 32 * kb, lane), msk, bacc);
            }
        }
        if (tb == 1) {
            if (OUT && c31 == 0) {
#pragma unroll
                for (int rg = 0; rg < 16; ++rg) REF[32 * kb + crow(rg, h)] = bacc[rg];
            }
            if (c31 == 31) {
#pragma unroll
                for (int rg = 0; rg < 16; ++rg) { const int k = 32 * kb + crow(rg, h); TOT[k] = bacc[rg]; DEC[k] = exn(bacc[rg]); if (!OUT) stot[rg] += bacc[rg]; }
            }
        }
        __syncthreads();
#pragma unroll
        for (int g = 0; g < 4; ++g) {
            const int k4 = 32 * kb + 8 * g + 4 * h, toff = swz(tpos, k4);
            const u32x2 lw = *(const LAS u32x2*)(L + T_LF + toff);
            const f32x4 tot4 = *(const LAS f32x4*)(TOT + k4);
            const float lfv[4] = {bflo(lw.x), bfhi(lw.x), bflo(lw.y), bfhi(lw.y)};
            float kk[4], ke[4];
#pragma unroll
            for (int i = 0; i < 4; ++i) { kk[i] = 1.0f - exn(lfv[i]); ke[i] = kk[i] * exn(tot4[i] - bacc[4 * g + i]); }
            *(LAS u32x2*)(L + T_KE + toff) = pack4(ke[0], ke[1], ke[2], ke[3]);
            if (OUT) {
                const u32x2 qw = *(const LAS u32x2*)(L + T_Q + toff);
                const f32x4 ref4 = *(const LAS f32x4*)(REF + k4);
                const float qv[4] = {bflo(qw.x), bfhi(qw.x), bflo(qw.y), bfhi(qw.y)};
                float qd[4], kd[4], qr[4];
#pragma unroll
                for (int i = 0; i < 4; ++i) { const float bb = bacc[4 * g + i]; const float x = fminf(fmaxf(bb - ref4[i], -80.f), 80.f);
                    qd[i] = qv[i] * exn(x); kd[i] = kk[i] * exn(-x); qr[i] = qv[i] * exn(bb); }
                *(LAS u32x2*)(L + T_Q + toff) = pack4(qd[0], qd[1], qd[2], qd[3]);
                *(LAS u32x2*)(L + T_LF + toff) = pack4(kd[0], kd[1], kd[2], kd[3]);
                *(LAS u32x2*)(L + T_QR + toff) = pack4(qr[0], qr[1], qr[2], qr[3]);
            }
        }
        __syncthreads();
        f32x16 acco = (f32x16){};
        if (OUT) {
#pragma unroll
            for (int ks = 0; ks < 8; ++ks) acco = MFMA32(frag_rm_s(L + T_QR, 32 * tcb, 16 * ks, lane), frag_rm_s(L + T_ST, 32 * tv, 16 * ks, lane), acco);
            if (w < 3) {
                const int ts = (w == 2) ? 1 : 0, tc = (w >= 1) ? 1 : 0; f32x16 aa = (f32x16){};
#pragma unroll
                for (int ks = 0; ks < 8; ++ks) aa = MFMA32(frag_rm_s(L + T_LF, 32 * ts, 16 * ks, lane), frag_rm_s(L + T_Q, 32 * tc, 16 * ks, lane), aa);
                const int cc = 32 * tc + c31;
#pragma unroll
                for (int gq = 0; gq < 4; ++gq) { float v4[4];
#pragma unroll
                    for (int i = 0; i < 4; ++i) { const int s = 32 * ts + 8 * gq + 4 * h + i; v4[i] = (s <= cc) ? aa[4 * gq + i] : 0.f; }
                    *(LAS u32x2*)(L + T_AM + cc * AMP + (32 * ts + 8 * gq + 4 * h) * 2) = pack4(v4[0], v4[1], v4[2], v4[3]); }
            }
            __syncthreads();
        }
        if (ci + 1 < 16) HG_ST_LQ();
        if (OUT) {
#pragma unroll
            for (int ks = 0; ks < 4; ++ks) if (ks < 2 || tcb == 1) acco = MFMA32(frag_rm(L + T_AM, AMP, 32 * tcb, 16 * ks, lane), frag_tr_s(L + T_V, 16 * ks, 32 * tv, lane), acco);
        }
        {
            float dk[16];
#pragma unroll
            for (int rg = 0; rg < 16; ++rg) dk[rg] = DEC[32 * tk + crow(rg, h)];
#pragma unroll
            for (int n = 0; n < 2; ++n) {
#pragma unroll
                for (int rg = 0; rg < 16; ++rg) accS[n][rg] *= dk[rg];
#pragma unroll
                for (int ks = 0; ks < 4; ++ks) accS[n] = MFMA32(frag_tr_s(L + T_KE, 16 * ks, 32 * tk, lane), frag_tr_s(L + T_V, 16 * ks, 32 * (2 * tvp + n), lane), accS[n]);
            }
        }
        if (OUT) {
#pragma unroll
            for (int n = 0; n < 2; ++n)
#pragma unroll
                for (int gq = 0; gq < 4; ++gq)
                    *(LAS u32x2*)(L + T_ST + swz(32 * (2 * tvp + n) + c31, 32 * tk + 8 * gq + 4 * h)) = pack4(accS[n][4 * gq], accS[n][4 * gq + 1], accS[n][4 * gq + 2], accS[n][4 * gq + 3]);
#pragma unroll
            for (int rg = 0; rg < 16; ++rg) *(LAS bf16*)(L + T_QR + swz(32 * tcb + crow(rg, h), 32 * tv + c31)) = f2bf(acco[rg]);
        }
        __syncthreads();
        if (ci + 1 < 16) HG_ST_V();
        if (OUT) {
#pragma unroll
            for (int i = 0; i < 2; ++i) { const int p = p0 + srow + 32 * i, t = dir ? (SEQ - 1 - p) : p;
                const u32x4 ov = *(const LAS u32x4*)(L + T_QR + swz(srow + 32 * i, spart * 8));
                if (STORE || ov.x == 0x12345678u) *(u32x4*)(og + ((size_t)head * SEQ + t) * 128 + spart * 8) = ov; }
        }
    }
    if (!OUT) {
        float* Uu = Ust + (size_t)u * 16384;
#pragma unroll
        for (int n = 0; n < 2; ++n)
#pragma unroll
            for (int rg = 0; rg < 16; ++rg) Uu[(32 * tk + crow(rg, h)) * 128 + 32 * (2 * tvp + n) + c31] = accS[n][rg];
        if (tb == 1 && c31 == 31) {
#pragma unroll
            for (int rg = 0; rg < 16; ++rg) Dt[(size_t)u * 128 + 32 * kb + crow(rg, h)] = exn(stot[rg]);
        }
    }
    __syncthreads();
#undef HG_LOAD
#undef HG_ST_LQ
#undef HG_ST_V
}
__device__ __forceinline__ void hgrn_combine(Frame& F, const bf16* of, const bf16* ob, const bf16* gs, const float* nw, bf16* yh) {
    const int gt = F.bid * NTH + F.tid, NGT = F.G * NTH;
    for (int idx = gt; idx < SEQ * 128; idx += NGT) {
        const int part = idx & 15, head = (idx >> 4) & 7, tok = idx >> 7; const size_t off = (size_t)tok * 1024 + head * 128 + part * 8, offh = ((size_t)head * SEQ + tok) * 128 + part * 8;
        const u32x4 a = *(const u32x4*)(of + offh), b = *(const u32x4*)(ob + offh), gg = *(const u32x4*)(gs + offh);
        float o[8] = {bflo(a.x) + bflo(b.x), bfhi(a.x) + bfhi(b.x), bflo(a.y) + bflo(b.y), bfhi(a.y) + bfhi(b.y), bflo(a.z) + bflo(b.z), bfhi(a.z) + bfhi(b.z), bflo(a.w) + bflo(b.w), bfhi(a.w) + bfhi(b.w)};
        float ss = 0.f;
#pragma unroll
        for (int i = 0; i < 8; ++i) ss += o[i] * o[i];
        ss += __shfl_xor(ss, 1); ss += __shfl_xor(ss, 2); ss += __shfl_xor(ss, 4); ss += __shfl_xor(ss, 8);
        const float r = __builtin_amdgcn_rsqf(ss * (1.0f / 128.0f) + EPS);
        const float gv[8] = {bflo(gg.x), bfhi(gg.x), bflo(gg.y), bfhi(gg.y), bflo(gg.z), bfhi(gg.z), bflo(gg.w), bfhi(gg.w)};
        const f32x4 n0 = *(const f32x4*)(nw + part * 8), n1 = *(const f32x4*)(nw + part * 8 + 4);
        const float nv[8] = {n0.x, n0.y, n0.z, n0.w, n1.x, n1.y, n1.z, n1.w};
#pragma unroll
        for (int i = 0; i < 8; ++i) o[i] = o[i] * r * nv[i] * gv[i];
        u32x4 wv; wv.x = pk2(o[0], o[1]); wv.y = pk2(o[2], o[3]); wv.z = pk2(o[4], o[5]); wv.w = pk2(o[6], o[7]);
        *(u32x4*)(yh + off) = wv;
    }
}

struct Params { const float* in[18]; float* out; unsigned char* ws; int ph_lo, ph_hi; };
constexpr int NPHASE = 17;
__global__ void __launch_bounds__(NTH, 2) mk_fwd(Params P) {
    extern __shared__ __attribute__((aligned(16))) unsigned char lds_raw[];
    Frame F;
    F.lds = (LAS unsigned char*)lds_raw;
    F.tid = threadIdx.x; F.lane = F.tid & 63; F.wave = __builtin_amdgcn_readfirstlane(F.tid >> 6); F.G = gridDim.x; F.bid = blockIdx.x;
#pragma unroll
    for (int i = 0; i < 18; ++i) F.in[i] = P.in[i];
    F.out = P.out; F.ws = P.ws;
    unsigned char* ws = P.ws;
    bf16* WFI = (bf16*)(ws + WS_WFI); bf16* WFO = (bf16*)(ws + WS_WFO); bf16* WIN = (bf16*)(ws + WS_WIN); bf16* WPA = (bf16*)(ws + WS_WPA); bf16* WPB = (bf16*)(ws + WS_WPB); bf16* WO = (bf16*)(ws + WS_WO);
    bf16* Hb = (bf16*)(ws + WS_H); bf16* ACT = (bf16*)(ws + WS_ACT); bf16* Yf = (bf16*)(ws + WS_Y); bf16* QKV = (bf16*)(ws + WS_QKV); bf16* YA = (bf16*)(ws + WS_YA);
    bf16* HG = (bf16*)(ws + WS_HG); float* LSE = (float*)(ws + WS_LSE); float* UST = (float*)(ws + WS_ST); float* DT = (float*)(ws + WS_DT);
    bf16* GA = (bf16*)(ws + WS_GA); bf16* GH = (bf16*)(ws + WS_GH); bf16* TT = (bf16*)(ws + WS_T); bf16* YM = (bf16*)(ws + WS_YM); bf16* Y2 = (bf16*)(ws + WS_Y2);
    const size_t SEC = (size_t)SEQ * 1024;
    const int lo = P.ph_lo, hi = P.ph_hi;
#if MK_SINGLE
    if (F.tid < 64) ((LAS unsigned*)(F.lds + MISC_OFF))[F.tid] = 0u;
    __syncthreads();
    XcdBarrier bar = xcd_barrier_post((unsigned*)ws, (volatile LAS unsigned*)(F.lds + MISC_OFF));
#define SEAM(k) do { if (lo <= (k) && (k) + 1 < hi) xcd_barrier(bar); } while (0)
#else
#define SEAM(k) do { } while (0)
#endif
#define IN(k) (lo <= (k) && (k) < hi)
#ifndef MK_DOUBLE
#define MK_DOUBLE 0
#endif
#define REPS(k) ((((MK_DOUBLE) >> (k)) & 1) ? 2 : 1)
#define REP_BEGIN(k) for (int rep_ = 0; rep_ < REPS(k); ++rep_) {
#if MK_SINGLE
#define REP_END(k) if (rep_ + 1 < REPS(k)) xcd_barrier(bar); }
#else
#define REP_END(k) }
#endif

    if (IN(0)) { REP_BEGIN(0)
        { const ConvJob jobs[6] = {{F.in[2], WFI, DM, 2 * DFF, 1, (DM / 64) * (2 * DFF / 64)}, {F.in[3], WFO, DFF, DM, 0, (DFF / 64) * (DM / 64)}, {F.in[6], WIN, DM, INW, 0, (DM / 64) * (INW / 64)},
                                    {F.in[10], WPA, 512, DM, 0, (512 / 64) * (DM / 64)}, {F.in[11], WPB, DM, DM, 0, (DM / 64) * (DM / 64)}, {F.in[12], WO, DM, DM, 0, (DM / 64) * (DM / 64)}};
          convert_weights<6>(F, jobs); }
        row_pass(F, F.in[0], nullptr, 0.f, nullptr, nullptr, F.in[1], Hb);
        __syncthreads();
        REP_END(0) SEAM(0);
    }
    if (IN(1)) { REP_BEGIN(1)
        pg8::Gemm g{Hb, WFI, SEQ, 2 * DFF, DM}; pg8::StaticOrder S; S.init(SEQ, 2 * DFF, F.G, F.bid);
        pg8::EpiSwiglu E{ACT, DFF};
        pg8::gemm_phase<pg8::EpiSwiglu, pg8::StaticOrder, true, true>(F.lds, g, S, E);
        REP_END(1) SEAM(1);
    }
    if (IN(2)) { REP_BEGIN(2)
        pg8::Gemm g{ACT, WFO, SEQ, DM, DFF}; pg8::StaticOrder S; S.init(SEQ, DM, F.G, F.bid);
        pg8::EpiSect<3> E{Yf, 1024, 0, 1.f, nullptr};
        pg8::gemm_phase<pg8::EpiSect<3>, pg8::StaticOrder, true, true>(F.lds, g, S, E);
        REP_END(2) SEAM(2);
    }
    if (IN(3)) { REP_BEGIN(3)
        row_pass(F, F.in[0], Yf, 0.5f, F.in[4], F.out, F.in[5], Hb);
        { const ConvJob jobs[2] = {{F.in[15], WFI, DM, 2 * DFF, 1, (DM / 64) * (2 * DFF / 64)}, {F.in[16], WFO, DFF, DM, 0, (DFF / 64) * (DM / 64)}};
          convert_weights<2>(F, jobs); }
        __syncthreads();
        REP_END(3) SEAM(3);
    }
    if (IN(4)) { REP_BEGIN(4)
        pg8::Gemm g{Hb, WIN, SEQ, 4608, DM}; pg8::StaticOrder S; S.init(SEQ, 4608, F.G, F.bid);
        pg8::EpiSect<0> E{QKV, 1536, (size_t)SEQ * 1536, 0.125f * LOG2E, nullptr};
        pg8::gemm_phase<pg8::EpiSect<0>, pg8::StaticOrder, true, true>(F.lds, g, S, E);
        REP_END(4) SEAM(4);
    }
    if (IN(5)) {
#if defined(MK_PRE) && (MK_PRE & 1)
        attn_phase<false>(F, QKV, QKV + (size_t)SEQ * 1536, QKV + (size_t)2 * SEQ * 1536, F.in[7], LSE); xcd_barrier(bar);
#endif
        attn_phase<true>(F, QKV, QKV + (size_t)SEQ * 1536, QKV + (size_t)2 * SEQ * 1536, F.in[7], LSE);
        SEAM(5);
    }
    if (IN(6)) { REP_BEGIN(6) attn_merge(F, QKV, LSE, YA); REP_END(6) SEAM(6); }
    if (IN(7)) { REP_BEGIN(7)
        pg8::Gemm g{Hb, WIN + (size_t)4608 * DM, SEQ, 5120, DM}; pg8::StaticOrder S; S.init(SEQ, 5120, F.G, F.bid);
        pg8::EpiSect<1> E{HG, 1024, SEC, 1.f, F.in[8]};
        pg8::gemm_phase<pg8::EpiSect<1>, pg8::StaticOrder, true, true>(F.lds, g, S, E);
        REP_END(7) SEAM(7);
    }
    if (IN(8)) { REP_BEGIN(8)
        for (int u = F.bid; u < 256; u += F.G) hgrn_unit<false>(F, u, HG, HG + ((u & 1) ? 2 : 1) * SEC, HG + 3 * SEC, nullptr, UST, DT);
        REP_END(8) SEAM(8);
    }
    if (IN(9)) {
#if defined(MK_PRE) && (MK_PRE & 2)
        for (int u = F.bid; u < 256; u += F.G) { bf16* lfp = HG + ((u & 1) ? 2 : 1) * SEC; hgrn_unit<true, false>(F, u, HG, lfp, HG + 3 * SEC, lfp, UST, DT); }
        xcd_barrier(bar);
#endif
        for (int u = F.bid; u < 256; u += F.G) { bf16* lfp = HG + ((u & 1) ? 2 : 1) * SEC; hgrn_unit<true>(F, u, HG, lfp, HG + 3 * SEC, lfp, UST, DT); }
        SEAM(9);
    }
    if (IN(10)) { REP_BEGIN(10) hgrn_combine(F, HG + SEC, HG + 2 * SEC, HG + 4 * SEC, F.in[9], HG); REP_END(10) SEAM(10); }
    if (IN(11)) { REP_BEGIN(11)
        pg8::StaticOrder S; S.init(SEQ, DM, F.G, F.bid);
        { pg8::Gemm g{Hb, WIN + (size_t)9728 * DM, SEQ, DM, DM}; pg8::EpiSect<2> E{GA, 1024, 0, 1.f, nullptr}; pg8::gemm_phase<pg8::EpiSect<2>, pg8::StaticOrder, true, true>(F.lds, g, S, E); }
        { pg8::Gemm g{YA, WPA, SEQ, DM, 512}; pg8::EpiGated<false> E{TT, GA, nullptr, DM}; pg8::gemm_phase<pg8::EpiGated<false>, pg8::StaticOrder, true, true>(F.lds, g, S, E); }
        { pg8::Gemm g{Hb, WIN + (size_t)10752 * DM, SEQ, DM, DM}; pg8::EpiSect<2> E{GH, 1024, 0, 1.f, nullptr}; pg8::gemm_phase<pg8::EpiSect<2>, pg8::StaticOrder, true, true>(F.lds, g, S, E); }
        { pg8::Gemm g{HG, WPB, SEQ, DM, DM}; pg8::EpiGated<true> E{YM, GH, TT, DM}; pg8::gemm_phase<pg8::EpiGated<true>, pg8::StaticOrder, true, true>(F.lds, g, S, E); }
        REP_END(11) SEAM(11);
    }
    if (IN(12)) { REP_BEGIN(12)
        pg8::Gemm g{YM, WO, SEQ, DM, DM}; pg8::StaticOrder S; S.init(SEQ, DM, F.G, F.bid);
        pg8::EpiSect<3> E{Y2, 1024, 0, 1.f, nullptr};
        pg8::gemm_phase<pg8::EpiSect<3>, pg8::StaticOrder, true, true>(F.lds, g, S, E);
        REP_END(12) SEAM(12);
    }
    if (IN(13)) { row_pass(F, F.out, Y2, 1.0f, F.in[13], F.out, F.in[14], Hb); SEAM(13); }
    if (IN(14)) { REP_BEGIN(14)
        pg8::Gemm g{Hb, WFI, SEQ, 2 * DFF, DM}; pg8::StaticOrder S; S.init(SEQ, 2 * DFF, F.G, F.bid);
        pg8::EpiSwiglu E{ACT, DFF};
        pg8::gemm_phase<pg8::EpiSwiglu, pg8::StaticOrder, true, true>(F.lds, g, S, E);
        REP_END(14) SEAM(14);
    }
    if (IN(15)) { REP_BEGIN(15)
        pg8::Gemm g{ACT, WFO, SEQ, DM, DFF}; pg8::StaticOrder S; S.init(SEQ, DM, F.G, F.bid);
        pg8::EpiSect<3> E{Yf, 1024, 0, 1.f, nullptr};
        pg8::gemm_phase<pg8::EpiSect<3>, pg8::StaticOrder, true, true>(F.lds, g, S, E);
        REP_END(15) SEAM(15);
    }
    if (IN(16)) { row_pass(F, F.out, Yf, 0.5f, F.in[17], F.out, nullptr, nullptr); }
#ifdef MK_EXTRA
    xcd_barrier(bar);
#if MK_EXTRA & 1
    attn_phase<true>(F, QKV, QKV + (size_t)SEQ * 1536, QKV + (size_t)2 * SEQ * 1536, F.in[7], LSE);
    xcd_barrier(bar);
#endif
#if MK_EXTRA & 2
    for (int u = F.bid; u < 256; u += F.G) hgrn_unit<false>(F, u, HG, HG + ((u & 1) ? 2 : 1) * SEC, HG + 3 * SEC, nullptr, UST, DT);
    xcd_barrier(bar);
#endif
#if MK_EXTRA & 4
    for (int u = F.bid; u < 256; u += F.G) { bf16* lfp = HG + ((u & 1) ? 2 : 1) * SEC; hgrn_unit<true>(F, u, HG, lfp, HG + 3 * SEC, lfp, UST, DT); }
    xcd_barrier(bar);
#endif
#if MK_EXTRA & 8
    attn_merge(F, QKV, LSE, YA); xcd_barrier(bar);
    hgrn_combine(F, HG + SEC, HG + 2 * SEC, HG + 4 * SEC, F.in[9], HG); xcd_barrier(bar);
#endif
#if MK_EXTRA & 16
    xcd_barrier(bar);
#endif
#if MK_EXTRA & 32
    row_pass(F, F.in[0], Yf, 0.5f, F.in[4], (float*)(ws + WS_BIG), F.in[5], Hb); xcd_barrier(bar);
#endif
#endif
#undef IN
#undef SEAM
}

extern "C" void kernel_launch(void* const* d_in, const int* in_sizes, int n_in, void* d_out, int out_size, void* d_ws, size_t ws_size, hipStream_t stream) {
    static int grid = 0;
    if (grid == 0) {
        if (n_in != 18 || out_size != SEQ * DM || ws_size < WS_END) { fprintf(stderr, "kernel_launch: unexpected shapes (n_in %d out %d ws %zu)\n", n_in, out_size, ws_size); grid = -1; return; }
        int dev = 0, cus = 0, per_cu = 0;
        if (hipGetDevice(&dev) != hipSuccess || hipDeviceGetAttribute(&cus, hipDeviceAttributeMultiprocessorCount, dev) != hipSuccess) { grid = -1; return; }
        if (hipFuncSetAttribute((const void*)mk_fwd, hipFuncAttributeMaxDynamicSharedMemorySize, LDS_BYTES) != hipSuccess) { fprintf(stderr, "kernel_launch: hipFuncSetAttribute failed\n"); grid = -1; return; }
        if (hipOccupancyMaxActiveBlocksPerMultiprocessor(&per_cu, (const void*)mk_fwd, NTH, LDS_BYTES) != hipSuccess || per_cu < 1) { fprintf(stderr, "kernel_launch: occupancy query says %d\n", per_cu); per_cu = 1; }
        (void)hipGetLastError();
        grid = cus;
    }
    if (grid < 0) return;
    Params p{};
    for (int i = 0; i < 18; ++i) p.in[i] = (const float*)d_in[i];
    p.out = (float*)d_out; p.ws = (unsigned char*)d_ws;
#if MK_SINGLE
    p.ph_lo = 0; p.ph_hi = NPHASE;
    if (hipMemsetAsync(d_ws, 0, CTL_ZERO_BYTES, stream) != hipSuccess) { fprintf(stderr, "kernel_launch: memset failed\n"); return; }
    void* args[] = {&p};
    hipError_t e = hipLaunchCooperativeKernel((const void*)mk_fwd, dim3(grid), dim3(NTH), args, LDS_BYTES, stream);
    if (e != hipSuccess) fprintf(stderr, "cooperative launch failed: %s (grid %d)\n", hipGetErrorString(e), grid);
#else
    for (int ph = 0; ph < NPHASE; ++ph) { p.ph_lo = ph; p.ph_hi = ph + 1; hipLaunchKernelGGL(mk_fwd, dim3(grid), dim3(NTH), LDS_BYTES, stream, p); }
#endif
}
```

```cpp
#include <hip/hip_runtime.h>
#include <hip/hip_cooperative_groups.h>
#include <cstdio>
#include <cstdint>
namespace pg8 {
#define PG8_LAS __attribute__((address_space(3)))
typedef unsigned short bf16_t;
typedef short bf16x8 __attribute__((ext_vector_type(8)));
typedef float f32x4 __attribute__((ext_vector_type(4)));
typedef unsigned u32x4 __attribute__((ext_vector_type(4)));
constexpr int BM = 256, BK = 64, HALF = 128, HTB = HALF * BK * 2  , STAGE_BYTES = 8 * HTB, NXCD = 8, WGM = 8;

__host__ __device__ __forceinline__ int lds_byte(int r, int c) { const int st = (r >> 4) * 2 + (c >> 5), rr = r & 15, cc = c & 31, ob = rr * 64 + cc * 2; return st * 1024 + (ob ^ (((ob >> 9) & 1) << 5)); }
__host__ __device__ __forceinline__ void stage_rc(int b, int& R, int& C) { const int st = b / 1024, sb = b % 1024, swz = sb ^ (((sb >> 9) & 1) << 5); R = (st >> 1) * 16 + swz / 64; C = (st & 1) * 32 + (swz % 64) / 2; }
__host__ __device__ __forceinline__ int perm32(int rho) { const int n = rho >> 4, i = rho & 15; return 8 * (i >> 2) + 4 * n + (i & 3); }

struct Unit { int pm, pn; };
struct Gemm { const bf16_t* A; const bf16_t* Bt; int M, N, K; };

struct StaticOrder {
    int nM, nN, nwg, G, c;
    __host__ __device__ void init(int M, int N, int G_, int c_) { nM = M / BM; nN = N / BM; nwg = nM * nN; G = G_; c = c_; }
    __host__ __device__ bool next(int i, Unit& u) const {
        const long L = (long)i * G + c; if (L >= nwg) return false;
        int wgid = (int)L; { const int q = nwg / NXCD, r = nwg % NXCD, xcd = wgid % NXCD, off = wgid / NXCD; wgid = (xcd < r ? xcd * (q + 1) : r * (q + 1) + (xcd - r) * q) + off; }
        const int nig = WGM * nN, gid = wgid / nig, fm = gid * WGM, gsz = (nM - fm) < WGM ? (nM - fm) : WGM;
        u.pm = fm + ((wgid % nig) % gsz); u.pn = (wgid % nig) / gsz; return true;
    }
    __device__ __forceinline__ void a_ready(const Unit&) const {}
    __device__ __forceinline__ void done(const Unit&) const {}
};

__device__ __forceinline__ unsigned cvt_pk_bf16(float lo, float hi) { unsigned r; asm volatile("v_cvt_pk_bf16_f32 %0, %1, %2" : "=v"(r) : "v"(lo), "v"(hi)); return r; }
typedef float f32x2 __attribute__((ext_vector_type(2)));
typedef __bf16 bf16x2v __attribute__((ext_vector_type(2)));
__device__ __forceinline__ unsigned pk2(float lo, float hi) { f32x2 v = {lo, hi}; bf16x2v b = __builtin_convertvector(v, bf16x2v); return __builtin_bit_cast(unsigned, b); }
__device__ __forceinline__ float bflo(unsigned w) { return __uint_as_float(w << 16); }
__device__ __forceinline__ float bfhi(unsigned w) { return __uint_as_float(w & 0xffff0000u); }
__device__ __forceinline__ float sigmoid_f(float x) { return __builtin_amdgcn_rcpf(1.0f + __builtin_amdgcn_exp2f(-1.4426950408889634f * x)); }
__device__ __forceinline__ float silu_f(float x) { return x * sigmoid_f(x); }
__device__ __forceinline__ u32x4 pack8(const f32x4& a, const f32x4& b) { u32x4 w; w.x = pk2(a[0], a[1]); w.y = pk2(a[2], a[3]); w.z = pk2(b[0], b[1]); w.w = pk2(b[2], b[3]); return w; }

struct EpiSwiglu {
    static constexpr bool PERM = true, AFTER_DRAIN = false;
    bf16_t* O; int ldc;
    __device__ __forceinline__ void operator()(const f32x4 (&acc)[2][2][4][2], const Unit& u, int wr, int wc, int fr, int fq) const {
        const int row0 = u.pm * BM + wr * 64 + fr, col0 = u.pn * HALF + wc * 32 + 8 * fq;
#pragma unroll
        for (int ai = 0; ai < 2; ++ai)
#pragma unroll
            for (int m = 0; m < 4; ++m) {
                bf16_t* rowp = O + (size_t)(row0 + ai * HALF + m * 16) * ldc + col0;
                f32x4 r0, r1;
#pragma unroll
                for (int i = 0; i < 4; ++i) { r0[i] = silu_f(acc[ai][0][m][0][i]) * acc[ai][1][m][0][i]; r1[i] = silu_f(acc[ai][0][m][1][i]) * acc[ai][1][m][1][i]; }
                *(u32x4*)rowp = pack8(r0, r1);
            }
    }
};
struct EpiF32 {
    static constexpr bool PERM = false, AFTER_DRAIN = false;
    float* O; int ldc;
    __device__ __forceinline__ void operator()(const f32x4 (&acc)[2][2][4][2], const Unit& u, int wr, int wc, int fr, int fq) const {
        const int row0 = u.pm * BM + wr * 64 + fr, col0 = u.pn * BM + wc * 32 + 4 * fq;
#pragma unroll
        for (int ai = 0; ai < 2; ++ai)
#pragma unroll
            for (int m = 0; m < 4; ++m) {
                float* rowp = O + (size_t)(row0 + ai * HALF + m * 16) * ldc + col0;
#pragma unroll
                for (int bj = 0; bj < 2; ++bj)
#pragma unroll
                    for (int n = 0; n < 2; ++n) *(f32x4*)(rowp + bj * HALF + n * 16) = acc[ai][bj][m][n];
            }
    }
};
template <int MODE> struct EpiSect {
    static constexpr bool PERM = true, AFTER_DRAIN = false;
    bf16_t* O; int sec_cols; size_t sec_stride; float scale0; const float* lbraw;
    __device__ __forceinline__ void operator()(const f32x4 (&acc)[2][2][4][2], const Unit& u, int wr, int wc, int fr, int fq) const {
        const int row0 = u.pm * BM + wr * 64 + fr; const int colt = u.pn * BM; const int sec = colt / sec_cols; const int ch0 = colt - sec * sec_cols + wc * 32 + 8 * fq;
        bf16_t* base = O + (size_t)sec * sec_stride;
        int grp = 0, hbase = 0, cin = ch0;
        if (MODE == 0) { grp = ch0 >> 9; hbase = (ch0 >> 6) & 7; cin = ch0 & 63; }
        if (MODE == 1) { hbase = ch0 >> 7; cin = ch0 & 127; }
        float lb[2][8];
        if (MODE == 1 && (sec == 1 || sec == 2)) {
#pragma unroll
            for (int bj = 0; bj < 2; ++bj)
#pragma unroll
                for (int i = 0; i < 8; ++i) { const int ch = ch0 + bj * HALF + i; lb[bj][i] = sigmoid_f(lbraw[(sec - 1) * 2048 + ch] - lbraw[(sec - 1) * 2048 + 1024 + ch]); }
        }
#pragma unroll
        for (int ai = 0; ai < 2; ++ai)
#pragma unroll
            for (int m = 0; m < 4; ++m) {
                const int row = row0 + ai * HALF + m * 16;
                bf16_t* rowp = base + (size_t)row * sec_cols + ch0; size_t bjstep = HALF;
                if (MODE == 0) { const int dsh = 2 * grp, sidx = ((row & ((1 << dsh) - 1)) << (14 - dsh)) + (row >> dsh);
                    rowp = base + ((size_t)((grp * 8 + hbase) * 16384 + sidx) << 6) + cin; bjstep = (size_t)2 * 16384 * 64; }
                if (MODE == 1) { rowp = base + ((size_t)(hbase * 16384 + row) << 7) + cin; bjstep = (size_t)16384 * 128; }
#pragma unroll
                for (int bj = 0; bj < 2; ++bj) {
                    f32x4 v0 = acc[ai][bj][m][0], v1 = acc[ai][bj][m][1];
                    if (MODE == 0) { if (sec == 0) { v0 = v0 * scale0; v1 = v1 * scale0; } }
                    else if (MODE == 3) { }
                    else if (MODE == 2) {
#pragma unroll
                        for (int i = 0; i < 4; ++i) { v0[i] = sigmoid_f(v0[i]); v1[i] = sigmoid_f(v1[i]); }
                    } else {
                        if (sec == 0 || sec == 4) {
#pragma unroll
                            for (int i = 0; i < 4; ++i) { v0[i] = silu_f(v0[i]); v1[i] = silu_f(v1[i]); }
                        } else if (sec == 1 || sec == 2) {
#pragma unroll
                            for (int i = 0; i < 4; ++i) {
                                v0[i] = log1pf(-(1.0f - lb[bj][i]) * sigmoid_f(-v0[i])); v1[i] = log1pf(-(1.0f - lb[bj][4 + i]) * sigmoid_f(-v1[i])); }
                        }
                    }
                    *(u32x4*)(rowp + bj * bjstep) = pack8(v0, v1);
                }
            }
    }
};
template <bool ADD> struct EpiGated {
    static constexpr bool PERM = true, AFTER_DRAIN = false;
    bf16_t* O; const bf16_t* G; const bf16_t* T; int ldc;
    __device__ __forceinline__ void operator()(const f32x4 (&acc)[2][2][4][2], const Unit& u, int wr, int wc, int fr, int fq) const {
        const int row0 = u.pm * BM + wr * 64 + fr, col0 = u.pn * BM + wc * 32 + 8 * fq;
#pragma unroll
        for (int ai = 0; ai < 2; ++ai)
#pragma unroll
            for (int m = 0; m < 4; ++m) {
                const size_t off = (size_t)(row0 + ai * HALF + m * 16) * ldc + col0;
#pragma unroll
                for (int bj = 0; bj < 2; ++bj) {
                    const u32x4 gw = *(const u32x4*)(G + off + bj * HALF);
                    f32x4 v0 = acc[ai][bj][m][0], v1 = acc[ai][bj][m][1];
                    v0[0] *= bflo(gw.x); v0[1] *= bfhi(gw.x); v0[2] *= bflo(gw.y); v0[3] *= bfhi(gw.y);
                    v1[0] *= bflo(gw.z); v1[1] *= bfhi(gw.z); v1[2] *= bflo(gw.w); v1[3] *= bfhi(gw.w);
                    if (ADD) { const u32x4 tw = *(const u32x4*)(T + off + bj * HALF);
                        v0[0] += bflo(tw.x); v0[1] += bfhi(tw.x); v0[2] += bflo(tw.y); v0[3] += bfhi(tw.y);
                        v1[0] += bflo(tw.z); v1[1] += bfhi(tw.z); v1[2] += bflo(tw.w); v1[3] += bfhi(tw.w); }
                    *(u32x4*)(O + off + bj * HALF) = pack8(v0, v1);
                }
            }
    }
};
template <class Epi, class Sched, bool ALIGN_EPI = false, bool SP2 = false>
__device__ __forceinline__ void gemm_phase(PG8_LAS unsigned char* lds, const Gemm g, const Sched& S, const Epi& E) {
    const int tid = threadIdx.x, wid = __builtin_amdgcn_readfirstlane(tid >> 6), lane = tid & 63, wr = wid >> 2, wc = wid & 3, fr = lane & 15, fq = lane >> 4;
    const int K = g.K, nt = K / BK;
    unsigned voffA[2], voffB[2];
#pragma unroll
    for (int i = 0; i < 2; ++i) { int R, C; stage_rc(tid * 16 + i * 8192, R, C); const int Rb = Epi::PERM ? ((R & ~31) + perm32(R & 31)) : R;
        voffA[i] = (unsigned)(R * K + C) * 2u; voffB[i] = (unsigned)(Rb * K + C) * 2u; }
    const size_t kstep = (size_t)(BK * 2);
    const size_t hstep = (size_t)HALF * K * 2;
    const size_t tstep = 2 * hstep;
    const unsigned ldsw = (unsigned)wid * 1024u;
    const int aoff = lds_byte(wr * 64 + fr, fq * 8), boff = lds_byte(wc * 32 + fr, fq * 8);
#define PG8_SA(b, h) (((b) * 2 + (h)) * HTB)
#define PG8_SB(b, h) ((4 + (b) * 2 + (h)) * HTB)
#define PG8_STAGE(bufoff, gbase, voff) do { _Pragma("unroll") for (int _i = 0; _i < 2; ++_i) \
        __builtin_amdgcn_global_load_lds((const unsigned*)((const char*)(gbase) + (voff)[_i]), (PG8_LAS unsigned*)(lds + (bufoff) + ldsw + _i * 8192), 16, 0, 0); } while (0)
#define PG8_LDA(dst, b, h) do { _Pragma("unroll") for (int m = 0; m < 4; ++m) _Pragma("unroll") for (int k = 0; k < 2; ++k) dst[m][k] = *(const PG8_LAS bf16x8*)(lds + PG8_SA(b, h) + aoff + m * 2048 + k * 1024); } while (0)
#define PG8_LDB(dst, b, h) do { _Pragma("unroll") for (int n = 0; n < 2; ++n) _Pragma("unroll") for (int k = 0; k < 2; ++k) dst[n][k] = *(const PG8_LAS bf16x8*)(lds + PG8_SB(b, h) + boff + n * 2048 + k * 1024); } while (0)
#define PG8_MMA(ai, bj, At, Bt) do { __builtin_amdgcn_s_setprio(1); _Pragma("unroll") for (int m = 0; m < 4; ++m) _Pragma("unroll") for (int n = 0; n < 2; ++n) _Pragma("unroll") for (int k = 0; k < 2; ++k) \
        acc[ai][bj][m][n] = __builtin_amdgcn_mfma_f32_16x16x32_bf16(Bt[n][k], At[m][k], acc[ai][bj][m][n], 0, 0, 0); __builtin_amdgcn_s_setprio(0); } while (0)
#define PG8_WAIT_V(n) asm volatile("s_waitcnt vmcnt(" #n ")" ::: "memory")
#define PG8_WAIT_L(n) asm volatile("s_waitcnt lgkmcnt(" #n ")" ::: "memory")
#define PG8_BAR __builtin_amdgcn_s_barrier()
#define PG8_SCHED __builtin_amdgcn_sched_barrier(0)
    Unit cur, nxt; int ui = 0;
    if (!S.next(0, cur)) return;
    f32x4 acc[2][2][4][2];
#pragma unroll
    for (int a = 0; a < 2; ++a)
#pragma unroll
        for (int b = 0; b < 2; ++b)
#pragma unroll
            for (int m = 0; m < 4; ++m)
#pragma unroll
                for (int n = 0; n < 2; ++n) acc[a][b][m][n] = (f32x4){0.f, 0.f, 0.f, 0.f};
    bf16x8 At[4][2], B0[2][2], B1[2][2];
    const char* cA = (const char*)g.A + (size_t)cur.pm * tstep; const char* cB = (const char*)g.Bt + (size_t)cur.pn * tstep;
    S.a_ready(cur);
    if constexpr (SP2) {
        PG8_STAGE(PG8_SB(0, 0), cB, voffB); PG8_STAGE(PG8_SB(0, 1), cB + hstep, voffB); PG8_STAGE(PG8_SA(0, 0), cA, voffA); PG8_STAGE(PG8_SA(0, 1), cA + hstep, voffA);
        if (wr == 1) PG8_BAR;
        PG8_WAIT_V(2); PG8_BAR;
        PG8_STAGE(PG8_SB(1, 0), cB + kstep, voffB); PG8_STAGE(PG8_SA(1, 0), cA + kstep, voffA); PG8_STAGE(PG8_SB(1, 1), cB + hstep + kstep, voffB);
        PG8_WAIT_V(6); PG8_BAR;
    } else {
        PG8_STAGE(PG8_SB(0, 0), cB, voffB); PG8_STAGE(PG8_SA(0, 0), cA, voffA); PG8_STAGE(PG8_SB(0, 1), cB + hstep, voffB); PG8_STAGE(PG8_SA(0, 1), cA + hstep, voffA);
        if (wr == 1) PG8_BAR;
        PG8_WAIT_V(4); PG8_BAR;
        PG8_STAGE(PG8_SB(1, 0), cB + kstep, voffB); PG8_STAGE(PG8_SA(1, 0), cA + kstep, voffA); PG8_STAGE(PG8_SB(1, 1), cB + hstep + kstep, voffB);
        PG8_WAIT_V(6); PG8_BAR;
    }
    for (;;) {
        const bool has_next = S.next(ui + 1, nxt);
        const char* nA = has_next ? (const char*)g.A + (size_t)nxt.pm * tstep : cA; const char* nB = has_next ? (const char*)g.Bt + (size_t)nxt.pn * tstep : cB;
        for (int t = 0; t < nt; t += 2) {
            const bool last = (t == nt - 2);
            const char* a1 = cA + (size_t)(t + 1) * kstep;
            const char* a2 = last ? nA : cA + (size_t)(t + 2) * kstep; const char* b2 = last ? nB : cB + (size_t)(t + 2) * kstep;
            const char* a3 = a2 + kstep; const char* b3 = b2 + kstep;
            if (last && has_next) S.a_ready(nxt);
            if constexpr (SP2) {
            PG8_LDB(B0, 0, 0); PG8_LDB(B1, 0, 1); PG8_SCHED; PG8_LDA(At, 0, 0); PG8_STAGE(PG8_SA(1, 1), a1 + hstep, voffA);
            PG8_WAIT_V(8); PG8_WAIT_L(0); PG8_BAR; PG8_MMA(0, 0, At, B0); PG8_MMA(0, 1, At, B1); PG8_BAR; PG8_SCHED;
            PG8_LDA(At, 0, 1); PG8_STAGE(PG8_SB(0, 0), b2, voffB); PG8_STAGE(PG8_SB(0, 1), b2 + hstep, voffB); PG8_STAGE(PG8_SA(0, 0), a2, voffA);
            PG8_WAIT_V(8); PG8_WAIT_L(0); PG8_BAR; PG8_MMA(1, 0, At, B0); PG8_MMA(1, 1, At, B1); PG8_BAR; PG8_SCHED;
            PG8_LDB(B0, 1, 0); PG8_LDB(B1, 1, 1); PG8_SCHED; PG8_LDA(At, 1, 0); PG8_STAGE(PG8_SA(0, 1), a2 + hstep, voffA);
            PG8_WAIT_V(8); PG8_WAIT_L(0); PG8_BAR; PG8_MMA(0, 0, At, B0); PG8_MMA(0, 1, At, B1); PG8_BAR; PG8_SCHED;
            PG8_LDA(At, 1, 1); PG8_STAGE(PG8_SB(1, 0), b3, voffB); PG8_STAGE(PG8_SB(1, 1), b3 + hstep, voffB); PG8_STAGE(PG8_SA(1, 0), a3, voffA);
            PG8_WAIT_V(8); PG8_WAIT_L(0); PG8_BAR; PG8_MMA(1, 0, At, B0); PG8_MMA(1, 1, At, B1); PG8_BAR; PG8_SCHED;
            } else {
            PG8_LDB(B0, 0, 0); PG8_SCHED; PG8_LDA(At, 0, 0); PG8_STAGE(PG8_SA(1, 1), a1 + hstep, voffA);
            PG8_WAIT_L(8); PG8_BAR; PG8_WAIT_L(0); PG8_MMA(0, 0, At, B0); PG8_BAR; PG8_SCHED;
            PG8_LDB(B1, 0, 1); PG8_STAGE(PG8_SB(0, 0), b2, voffB);
            PG8_BAR; PG8_WAIT_L(0); PG8_MMA(0, 1, At, B1); PG8_BAR;
            PG8_LDA(At, 0, 1); PG8_STAGE(PG8_SA(0, 0), a2, voffA);
            PG8_BAR; PG8_WAIT_L(0); PG8_MMA(1, 0, At, B0); PG8_BAR; PG8_SCHED;
            PG8_STAGE(PG8_SB(0, 1), b2 + hstep, voffB);
            PG8_WAIT_V(6); PG8_BAR; PG8_MMA(1, 1, At, B1); PG8_BAR;
            PG8_LDB(B0, 1, 0); PG8_SCHED; PG8_LDA(At, 1, 0); PG8_STAGE(PG8_SA(0, 1), a2 + hstep, voffA);
            PG8_WAIT_L(8); PG8_BAR; PG8_WAIT_L(0); PG8_MMA(0, 0, At, B0); PG8_BAR; PG8_SCHED;
            PG8_LDB(B1, 1, 1); PG8_STAGE(PG8_SB(1, 0), b3, voffB);
            PG8_BAR; PG8_WAIT_L(0); PG8_MMA(0, 1, At, B1); PG8_BAR;
            PG8_LDA(At, 1, 1); PG8_STAGE(PG8_SA(1, 0), a3, voffA);
            PG8_BAR; PG8_WAIT_L(0); PG8_MMA(1, 0, At, B0); PG8_BAR; PG8_SCHED;
            PG8_STAGE(PG8_SB(1, 1), b3 + hstep, voffB);
            PG8_WAIT_V(6); PG8_BAR; PG8_MMA(1, 1, At, B1); PG8_BAR;
            }
        }
        if constexpr (ALIGN_EPI) { if (wr == 0) PG8_BAR; }
        if constexpr (!Epi::AFTER_DRAIN) { E(acc, cur, wr, wc, fr, fq); S.done(cur); }
        if (!has_next) break;
#pragma unroll
        for (int a = 0; a < 2; ++a)
#pragma unroll
            for (int b = 0; b < 2; ++b)
#pragma unroll
                for (int m = 0; m < 4; ++m)
#pragma unroll
                    for (int n = 0; n < 2; ++n) acc[a][b][m][n] = (f32x4){0.f, 0.f, 0.f, 0.f};
        cur = nxt; cA = nA; cB = nB; ++ui;
        if constexpr (ALIGN_EPI) { if (wr == 1) PG8_BAR; }
    }
    PG8_WAIT_V(0);
    if constexpr (!ALIGN_EPI) { if (wr == 0) PG8_BAR; }
    PG8_BAR;
    if constexpr (Epi::AFTER_DRAIN) { E.fused(acc, cur, wr, wc, fr, fq, lds, wid, lane); S.done(cur); }
#undef PG8_SA
#undef PG8_SB
#undef PG8_STAGE
#undef PG8_LDA
#undef PG8_LDB
#undef PG8_MMA
#undef PG8_WAIT_V
#undef PG8_WAIT_L
#undef PG8_BAR
#undef PG8_SCHED
}
}

namespace cg = cooperative_groups;
#define LAS __attribute__((address_space(3)))
typedef unsigned short bf16;
typedef float f32x4 __attribute__((ext_vector_type(4)));
typedef float f32x16 __attribute__((ext_vector_type(16)));
typedef short bf16x8 __attribute__((ext_vector_type(8)));
typedef short s16x4 __attribute__((ext_vector_type(4)));
typedef unsigned u32x4 __attribute__((ext_vector_type(4)));
typedef unsigned u32x2 __attribute__((ext_vector_type(2)));
using pg8::pk2; using pg8::bflo; using pg8::bfhi; using pg8::sigmoid_f;

#ifndef MK_SINGLE
#define MK_SINGLE 1
#endif

constexpr int SEQ = 16384, DM = 1024, DFF = 2816, INW = 11776, NWAVES = 8, NTH = 512;
constexpr float EPS = 1e-6f, LOG2E = 1.4426950408889634f;
constexpr int LDS_BYTES = 163840, MISC_OFF = LDS_BYTES - 256;
constexpr int CTL_ZERO_BYTES = 16384;
constexpr size_t MiB = 1u << 20;
constexpr size_t WS_WFI = 1 * MiB;
constexpr size_t WS_WFO = 12 * MiB;
constexpr size_t WS_WIN = 18 * MiB;
constexpr size_t WS_WPA = 41 * MiB;
constexpr size_t WS_WPB = 42 * MiB;
constexpr size_t WS_WO  = 44 * MiB;
constexpr size_t WS_ST  = 18 * MiB;
constexpr size_t WS_DT  = 34 * MiB;
constexpr size_t WS_LSE = 46 * MiB;
constexpr size_t WS_H   = 48 * MiB;
constexpr size_t WS_BIG = 80 * MiB;
constexpr size_t WS_ACT = WS_BIG;
constexpr size_t WS_Y   = WS_BIG + 88 * MiB;
constexpr size_t WS_QKV = WS_BIG;
constexpr size_t WS_YA  = 240 * MiB;
constexpr size_t WS_HG  = WS_BIG;
constexpr size_t WS_GA  = WS_BIG + 32 * MiB;
constexpr size_t WS_GH  = WS_BIG + 64 * MiB;
constexpr size_t WS_T   = WS_BIG + 96 * MiB;
constexpr size_t WS_YM  = WS_BIG + 128 * MiB;
constexpr size_t WS_Y2  = WS_BIG + 32 * MiB;
constexpr size_t WS_END = 256 * MiB;

__constant__ unsigned char T5BUCKET[3][129] = {
 {11,11,11,11,11,11,11,11,11,11,11,11,11,11,11,10,10,10,10,10,10,10,10,10,10,10,10,10,10,10,10,10,10,10,10,10,10,10,9,9,9,9,9,9,9,9,9,9,9,9,8,8,8,8,8,8,8,7,6,5,4,3,2,1,0,17,18,19,20,21,22,23,24,24,24,24,24,24,24,25,25,25,25,25,25,25,25,25,25,25,25,26,26,26,26,26,26,26,26,26,26,26,26,26,26,26,26,26,26,26,26,26,26,26,27,27,27,27,27,27,27,27,27,27,27,27,27,27,27},
 {13,13,13,13,13,13,13,13,13,13,13,13,13,13,13,13,13,13,13,13,13,13,13,12,12,12,12,12,12,12,12,12,12,12,12,12,12,12,12,12,12,12,11,11,11,11,11,11,11,11,11,11,10,10,10,10,10,10,9,9,9,8,8,4,0,20,24,24,25,25,25,26,26,26,26,26,26,27,27,27,27,27,27,27,27,27,27,28,28,28,28,28,28,28,28,28,28,28,28,28,28,28,28,28,28,28,29,29,29,29,29,29,29,29,29,29,29,29,29,29,29,29,29,29,29,29,29,29,29},
 {15,15,15,15,15,15,15,15,15,15,15,15,15,15,15,15,15,15,15,15,15,15,15,15,15,15,15,15,15,15,14,14,14,14,14,14,14,14,14,14,14,14,14,14,14,13,13,13,13,13,13,13,13,13,12,12,12,12,12,11,11,10,10,9,0,25,26,26,27,27,28,28,28,28,28,29,29,29,29,29,29,29,29,29,30,30,30,30,30,30,30,30,30,30,30,30,30,30,30,31,31,31,31,31,31,31,31,31,31,31,31,31,31,31,31,31,31,31,31,31,31,31,31,31,31,31,31,31,31}};

__device__ __forceinline__ float bf2f(bf16 b) { return __uint_as_float((unsigned)b << 16); }
__device__ __forceinline__ bf16 f2bf(float f) { return (bf16)(pk2(f, 0.f) & 0xffffu); }
__device__ __forceinline__ float wave_sum(float v) {
#pragma unroll
    for (int o = 1; o < 64; o <<= 1) v += __shfl_xor(v, o);
    return v;
}
__device__ __forceinline__ float ex2(float x) { return __builtin_amdgcn_exp2f(x); }
__device__ __forceinline__ float exn(float x) { return __builtin_amdgcn_exp2f(x * LOG2E); }

#define MFMA32(a, b, c) __builtin_amdgcn_mfma_f32_32x32x16_bf16((a), (b), (c), 0, 0, 0)
__device__ __forceinline__ bf16x8 frag_rm(const LAS unsigned char* X, int pitchB, int row0, int k0, int lane) {
    return *(const LAS bf16x8*)(X + (row0 + (lane & 31)) * pitchB + (k0 + 8 * (lane >> 5)) * 2);
}
typedef short v4i16_t __attribute__((ext_vector_type(4)));
__device__ __forceinline__ s16x4 tr_rd(const LAS unsigned char* p) { return __builtin_bit_cast(s16x4, __builtin_amdgcn_ds_read_tr16_b64_v4i16((LAS v4i16_t*)p)); }
__device__ __forceinline__ bf16x8 frag_tr(const LAS unsigned char* X, int pitchB, int k0, int col0, int lane) {
    const int G = lane >> 4, i = lane & 15, q = i >> 2, p = i & 3, h = G >> 1;
    const LAS unsigned char* a0 = X + (k0 + 8 * h + q) * pitchB + (col0 + 16 * (G & 1) + 4 * p) * 2;
    const s16x4 lo = tr_rd(a0), hi = tr_rd(a0 + 4 * pitchB);
    return (bf16x8){lo[0], lo[1], lo[2], lo[3], hi[0], hi[1], hi[2], hi[3]};
}
__device__ __forceinline__ bf16x8 frag_tr_perm(const LAS unsigned char* X, int pitchB, int k0, int col0, int lane) {
    const int G = lane >> 4, i = lane & 15, q = i >> 2, p = i & 3, h = G >> 1;
    const LAS unsigned char* a0 = X + (k0 + 4 * h + q) * pitchB + (col0 + 16 * (G & 1) + 4 * p) * 2;
    const s16x4 lo = tr_rd(a0), hi = tr_rd(a0 + 8 * pitchB);
    return (bf16x8){lo[0], lo[1], lo[2], lo[3], hi[0], hi[1], hi[2], hi[3]};
}
__device__ __forceinline__ int crow(int reg, int h) { return (reg & 3) + 8 * (reg >> 2) + 4 * h; }

#define XB_TMO      128
#define XB_XCNT(j)  (256  + 64 * (j))
#define XB_XSUB(j)  (1280 + 64 * (j))
#define XB_XGEN(j)  (2304 + 64 * (j))
#define XB_TOP      3328
#define XB_TOPGEN   3392
#define XCD_BAR_WORDS 3456
#define XB_SPIN_CAP (1u << 18)

__device__ __forceinline__ unsigned xb_ld(unsigned* p)              { return __hip_atomic_load(p, __ATOMIC_RELAXED, __HIP_MEMORY_SCOPE_AGENT); }
__device__ __forceinline__ unsigned xb_add(unsigned* p, unsigned v) { return __hip_atomic_fetch_add(p, v, __ATOMIC_RELAXED, __HIP_MEMORY_SCOPE_AGENT); }
__device__ __forceinline__ unsigned xb_xcc_id() { return (unsigned)__builtin_amdgcn_s_getreg((3 << 11) | 20) & 0xFu; }
#define XB_SPIN(cond, bar) do { unsigned _sp = 0; while (cond) { __builtin_amdgcn_s_sleep(1); \
    if ((++_sp & 255u) == 0u) { if (xb_ld(&(bar)[XB_TMO])) break; if (_sp > XB_SPIN_CAP) { atomicAdd(&(bar)[XB_TMO], 1u); break; } } } } while (0)

struct XcdBarrier {
    unsigned* bar; unsigned x;
    volatile LAS unsigned* st;
};

__device__ __forceinline__ XcdBarrier xcd_barrier_post(unsigned* bar, volatile LAS unsigned* st) {
    XcdBarrier b; b.bar = bar; b.x = xb_xcc_id(); b.st = st;
    if (threadIdx.x == 0) (void)xb_add(&bar[XB_XCNT(b.x)], 1u);
    return b;
}
__device__ __forceinline__ void xcd_barrier_complete(unsigned* bar, unsigned x, unsigned& nloc, unsigned& nx) {
    const unsigned G = gridDim.x * gridDim.y * gridDim.z;
    unsigned sum, cnt, mine, sp = 0u;
    for (;;) {
        sum = 0u; cnt = 0u; mine = 0u;
#pragma unroll
        for (unsigned j = 0; j < 16; ++j) { const unsigned c = xb_ld(&bar[XB_XCNT(j)]); sum += c; cnt += (c > 0u) ? 1u : 0u; mine = (j == x) ? c : mine; }
        if (sum == G) break;
        __builtin_amdgcn_s_sleep(1);
        if ((++sp & 255u) == 0u) { if (xb_ld(&bar[XB_TMO])) break; if (sp > XB_SPIN_CAP) { atomicAdd(&bar[XB_TMO], 1u); break; } }
    }
    nloc = mine > 0u ? mine : 1u; nx = cnt > 0u ? cnt : 1u;
}

__device__ __forceinline__ void xcd_barrier(const XcdBarrier& b) {
    asm volatile("s_waitcnt vmcnt(0)" ::: "memory");
    __syncthreads();
    if (threadIdx.x == 0) {
        unsigned* bar = b.bar;
        __builtin_amdgcn_s_waitcnt(0);
        unsigned nloc = b.st[0], nx = b.st[1];
        if (nloc == 0u) { xcd_barrier_complete(bar, b.x, nloc, nx); b.st[0] = nloc; b.st[1] = nx; }
        const unsigned old = xb_add(&bar[XB_XSUB(b.x)], 1u);
        const unsigned gen = old / nloc;
        if (old + 1u == (gen + 1u) * nloc) {
            __builtin_amdgcn_fence(__ATOMIC_RELEASE, "agent");
            asm volatile("s_waitcnt vmcnt(0)" ::: "memory");
            const unsigned og = xb_add(&bar[XB_TOP], 1u);
            const unsigned tg = og / nx;
            if (og + 1u == (tg + 1u) * nx) xb_add(&bar[XB_TOPGEN], 1u);
            else XB_SPIN(xb_ld(&bar[XB_TOPGEN]) == tg, bar);
            __builtin_amdgcn_fence(__ATOMIC_ACQUIRE, "agent");
            xb_add(&bar[XB_XGEN(b.x)], 1u);
            asm volatile("s_waitcnt vmcnt(0)" ::: "memory");
        } else {
            XB_SPIN(xb_ld(&bar[XB_XGEN(b.x)]) == gen, bar);
            __builtin_amdgcn_fence(__ATOMIC_ACQUIRE, "agent");
            asm volatile("s_waitcnt vmcnt(0)" ::: "memory");
        }
    }
    __syncthreads();
}

struct Frame {
    LAS unsigned char* lds;
    int tid, lane, wave, G, bid;
    const float* in[18]; float* out; unsigned char* ws;
};

struct ConvJob { const float* W; bf16* WT; int K, N, mapk, nitems; };
constexpr int CONV_SCR = 16896;
template <int NJ> __device__ __forceinline__ void conv_locate(const ConvJob (&jobs)[NJ], int it, ConvJob& J, int& k0, int& n0) {
    J = jobs[0]; bool found = false;
#pragma unroll
    for (int j = 0; j < NJ; ++j) { if (!found) { if (it < jobs[j].nitems || j == NJ - 1) { J = jobs[j]; found = true; } else it -= jobs[j].nitems; } }
    const int nblk = J.N >> 6; k0 = (it / nblk) << 6; n0 = (it % nblk) << 6;
}
template <int NJ> __device__ __forceinline__ void convert_weights(Frame& F, const ConvJob (&jobs)[NJ], int gw, int NGW) {
    LAS float* scr = (LAS float*)(F.lds + F.wave * CONV_SCR);
    const int lane = F.lane, r = lane >> 4, c4 = lane & 15;
    int total = 0;
#pragma unroll
    for (int j = 0; j < NJ; ++j) total += jobs[j].nitems;
    int it = gw; if (it >= total) return;
    ConvJob J; int k0, n0; conv_locate<NJ>(jobs, it, J, k0, n0);
    f32x4 v[16];
    { const float* src = J.W + (size_t)(k0 + r) * J.N + n0 + 4 * c4; const size_t st = (size_t)4 * J.N;
#pragma unroll
      for (int i = 0; i < 16; ++i) v[i] = *(const f32x4*)(src + i * st); }
    for (;;) {
#pragma unroll
        for (int i = 0; i < 16; ++i) { LAS float* d = scr + (4 * i + r) * 65 + 4 * c4; d[0] = v[i].x; d[1] = v[i].y; d[2] = v[i].z; d[3] = v[i].w; }
        const ConvJob C = J; const int ck0 = k0, cn0 = n0;
        const int nit = it + NGW; const bool more = nit < total;
        if (more) { conv_locate<NJ>(jobs, nit, J, k0, n0);
            const float* src = J.W + (size_t)(k0 + r) * J.N + n0 + 4 * c4; const size_t st = (size_t)4 * J.N;
#pragma unroll
            for (int i = 0; i < 16; ++i) v[i] = *(const f32x4*)(src + i * st); }
        asm volatile("s_waitcnt lgkmcnt(0)" ::: "memory");
        const int K = C.K; int drow0 = cn0;
        if (C.mapk == 1) drow0 = (cn0 < DFF) ? 256 * (cn0 / 128) + (cn0 % 128) : 256 * ((cn0 - DFF) / 128) + 128 + ((cn0 - DFF) % 128);
        bf16* dst = C.WT + (size_t)drow0 * K + ck0 + 8 * (lane & 7);
#pragma unroll
        for (int j = 0; j < 8; ++j) { const int n = (lane >> 3) + 8 * j; const LAS float* sp = scr + (8 * (lane & 7)) * 65 + n;
            u32x4 o; o.x = pk2(sp[0 * 65], sp[1 * 65]); o.y = pk2(sp[2 * 65], sp[3 * 65]); o.z = pk2(sp[4 * 65], sp[5 * 65]); o.w = pk2(sp[6 * 65], sp[7 * 65]);
            *(u32x4*)(dst + (size_t)n * K) = o; }
        asm volatile("s_waitcnt lgkmcnt(0)" ::: "memory");
        if (!more) break;
        it = nit;
    }
}
__device__ __forceinline__ void row_pass(Frame& F, const float* base, const bf16* y, float ysc, const float* gpost, float* outx, const float* gpre, bf16* hout) {
    const int gw = F.bid * NWAVES + F.wave, NGW = F.G * NWAVES, lane = F.lane;
    f32x4 xn[4]; u32x2 yn[4];
    int m = gw;
    if (m < SEQ) { const f32x4* b4 = (const f32x4*)(base + (size_t)m * DM) + lane;
#pragma unroll
        for (int j = 0; j < 4; ++j) xn[j] = b4[64 * j];
        if (y) { const u32x2* y4 = (const u32x2*)(y + (size_t)m * DM) + lane;
#pragma unroll
            for (int j = 0; j < 4; ++j) yn[j] = y4[64 * j]; } }
    for (; m < SEQ; m += NGW) {
        f32x4 xv[4]; u32x2 yw[4];
#pragma unroll
        for (int j = 0; j < 4; ++j) { xv[j] = xn[j]; yw[j] = yn[j]; }
        const int mn = m + NGW;
        if (mn < SEQ) { const f32x4* b4 = (const f32x4*)(base + (size_t)mn * DM) + lane;
#pragma unroll
            for (int j = 0; j < 4; ++j) xn[j] = b4[64 * j];
            if (y) { const u32x2* y4 = (const u32x2*)(y + (size_t)mn * DM) + lane;
#pragma unroll
                for (int j = 0; j < 4; ++j) yn[j] = y4[64 * j]; } }
        if (y) {
            f32x4 yv[4]; float s = 0.f;
#pragma unroll
            for (int j = 0; j < 4; ++j) { yv[j] = (f32x4){bflo(yw[j].x), bfhi(yw[j].x), bflo(yw[j].y), bfhi(yw[j].y)}; s += (yv[j].x * yv[j].x + yv[j].y * yv[j].y) + (yv[j].z * yv[j].z + yv[j].w * yv[j].w); }
            const float r = ysc * __builtin_amdgcn_rsqf(wave_sum(s) * (1.0f / DM) + EPS);
#pragma unroll
            for (int j = 0; j < 4; ++j) { const f32x4 g = ((const f32x4*)gpost)[64 * j + lane]; xv[j] = xv[j] + yv[j] * g * r; }
        }
        if (outx) { f32x4* o4 = (f32x4*)(outx + (size_t)m * DM) + lane;
#pragma unroll
            for (int j = 0; j < 4; ++j) o4[64 * j] = xv[j]; }
        if (hout) {
            float s = 0.f;
#pragma unroll
            for (int j = 0; j < 4; ++j) s += (xv[j].x * xv[j].x + xv[j].y * xv[j].y) + (xv[j].z * xv[j].z + xv[j].w * xv[j].w);
            const float r = __builtin_amdgcn_rsqf(wave_sum(s) * (1.0f / DM) + EPS);
            u32x2* o8 = (u32x2*)(hout + (size_t)m * DM) + lane;
#pragma unroll
            for (int j = 0; j < 4; ++j) { const f32x4 g = ((const f32x4*)gpre)[64 * j + lane]; const f32x4 v = xv[j] * g * r; u32x2 w; w.x = pk2(v.x, v.y); w.y = pk2(v.z, v.w); o8[64 * j] = w; }
        }
    }
}

constexpr int AT_PITCH = 144;
constexpr int AT_K = 0, AT_V = 384 * AT_PITCH, AT_BIAS = 2 * 384 * AT_PITCH, AT_O = AT_BIAS + 768, AT_OW = 32 * AT_PITCH;
static_assert(AT_O + 8 * AT_OW <= LDS_BYTES - 256, "attention LDS map");
struct AttnU { int g, hh, r, a0, d, L, hb; };
__device__ __forceinline__ AttnU attn_decode(int u) {
    AttnU A; A.g = u >> 9; const int rem = u & 511; A.hh = rem >> 6; const int blk = rem & 63;
    const int dsh = 2 * A.g, tsh = 6 - dsh; A.d = 1 << dsh; A.L = SEQ >> dsh;
    A.r = blk >> tsh; A.a0 = (blk & ((1 << tsh) - 1)) * 256; A.hb = (A.g * 8 + A.hh) * SEQ; return A;
}
template <bool STORE> __device__ __forceinline__ void attn_phase(Frame& F, bf16* Qg, const bf16* Kg, const bf16* Vg, const float* relb, float* lse) {
    const int tid = F.tid, lane = F.lane, w = F.wave, c = lane & 31, h = lane >> 5;
    LAS unsigned char* Kl = F.lds + AT_K; LAS unsigned char* Vl = F.lds + AT_V; LAS float* biasL = (LAS float*)(F.lds + AT_BIAS);
    u32x4 kv[6], vv[6]; bf16x8 qn[4]; float bn = 0.f;
#define AT_LOAD(A_) do { \
        { const int sp0_ = (A_).a0 - 64 + (tid >> 3); const long off0_ = ((long)(A_).hb + (long)(A_).r * (A_).L + sp0_) * 64 + (tid & 7) * 8; const long st_ = 64 * 64; \
          _Pragma("unroll") for (int i = 0; i < 6; ++i) { const int sp = sp0_ + 64 * i; const bool ok = (sp >= 0) && (sp < (A_).L); \
            kv[i] = ok ? *(const u32x4*)(Kg + (off0_ + i * st_)) : (u32x4){0u, 0u, 0u, 0u}; vv[i] = ok ? *(const u32x4*)(Vg + (off0_ + i * st_)) : (u32x4){0u, 0u, 0u, 0u}; } } \
        { const size_t qoff = ((size_t)(A_).hb + (size_t)(A_).r * (A_).L + (A_).a0 + 32 * w + c) * 64 + 8 * h; \
          _Pragma("unroll") for (int ks = 0; ks < 4; ++ks) qn[ks] = *(const bf16x8*)(Qg + qoff + 16 * ks); } \
        if (tid < 192) { const int bi_ = min(max(tid - 32, 0), 128); const float bv_ = relb[(int)T5BUCKET[(A_).g][bi_] * 24 + (A_).g * 8 + (A_).hh] * LOG2E; bn = (tid >= 32 && tid <= 160) ? bv_ : -1e30f; } } while (0)
    int u = F.bid; if (u >= 1536) return;
    AttnU A = attn_decode(u);
    AT_LOAD(A);
    for (;;) {
#pragma unroll
        for (int i = 0; i < 6; ++i) { const int cidx = tid + NTH * i, row = cidx >> 3, part = cidx & 7;
            *(LAS u32x4*)(Kl + row * AT_PITCH + part * 16) = kv[i]; *(LAS u32x4*)(Vl + row * AT_PITCH + part * 16) = vv[i]; }
        if (tid < 192) biasL[tid] = bn;
        bf16x8 qf[4];
#pragma unroll
        for (int ks = 0; ks < 4; ++ks) qf[ks] = qn[ks];
        const AttnU C = A; const int un = u + F.G; const bool more = un < 1536;
        __syncthreads();
        if (more) { A = attn_decode(un); AT_LOAD(A); }
        const int a0 = C.a0, L = C.L;
        const int tokq = C.r + C.d * (a0 + 32 * w + c);
        const int kp0 = a0 + 32 * w - 64;
        const bool edge = (kp0 < 0) || (kp0 + 160 > L);
        int lb_ = 32 + 4 * h - c; asm volatile("" : "+v"(lb_));
        const LAS float* bl = biasL + lb_;
        float mx = -1e30f, l = 0.f;
        f32x16 o[2]; o[0] = (f32x16){}; o[1] = (f32x16){};
#pragma unroll
        for (int ti = 0; ti < 5; ++ti) {
            const int kt = (ti == 0) ? 2 : (ti == 1) ? 1 : (ti == 2) ? 3 : (ti == 3) ? 0 : 4;
            f32x16 st = (f32x16){};
#pragma unroll
            for (int ks = 0; ks < 4; ++ks) st = MFMA32(frag_rm(Kl, AT_PITCH, 32 * w + 32 * kt, 16 * ks, lane), qf[ks], st);
            float tm = -1e30f;
#pragma unroll
            for (int rg = 0; rg < 16; ++rg) {
                const int kc = 32 * kt + (rg & 3) + 8 * (rg >> 2);
                float sv = st[rg] + bl[kc];
                if (edge) { const int kp = kp0 + kc + 4 * h; if (kp < 0 || kp >= L) sv = -1e30f; }
                st[rg] = sv; tm = fmaxf(tm, sv);
            }
            tm = fmaxf(tm, __shfl_xor(tm, 32));
            const float mn = fmaxf(mx, tm), alpha = ex2(mx - mn); mx = mn;
            float ls = 0.f; u32x4 pw[2];
#pragma unroll
            for (int sh = 0; sh < 2; ++sh) {
                float p[8];
#pragma unroll
                for (int j = 0; j < 8; ++j) { p[j] = ex2(st[8 * sh + j] - mn); ls += p[j]; }
                pw[sh].x = pk2(p[0], p[1]); pw[sh].y = pk2(p[2], p[3]); pw[sh].z = pk2(p[4], p[5]); pw[sh].w = pk2(p[6], p[7]);
            }
            l = l * alpha + ls;
            if (ti > 0) {
#pragma unroll
                for (int rg = 0; rg < 16; ++rg) { o[0][rg] *= alpha; o[1][rg] *= alpha; }
            }
#pragma unroll
            for (int sh = 0; sh < 2; ++sh) {
                const bf16x8 pb = __builtin_bit_cast(bf16x8, pw[sh]);
#pragma unroll
                for (int eh = 0; eh < 2; ++eh) o[eh] = MFMA32(frag_tr_perm(Vl, AT_PITCH, 32 * w + 32 * kt + 16 * sh, 32 * eh, lane), pb, o[eh]);
            }
        }
        l += __shfl_xor(l, 32);
        const float inv = 1.0f / l;
        LAS unsigned char* Ow = F.lds + AT_O + w * AT_OW;
#pragma unroll
        for (int eh = 0; eh < 2; ++eh)
#pragma unroll
            for (int gq = 0; gq < 4; ++gq) {
                u32x2 wv; wv.x = pk2(o[eh][4 * gq + 0] * inv, o[eh][4 * gq + 1] * inv); wv.y = pk2(o[eh][4 * gq + 2] * inv, o[eh][4 * gq + 3] * inv);
                *(LAS u32x2*)(Ow + c * AT_PITCH + (32 * eh + 8 * gq + 4 * h) * 2) = wv;
            }
        asm volatile("s_waitcnt lgkmcnt(0)" ::: "memory");
#pragma unroll
        for (int i = 0; i < 4; ++i) { const int row = (lane >> 3) + 8 * i, part = lane & 7;
            const u32x4 ov = *(const LAS u32x4*)(Ow + row * AT_PITCH + part * 16);
            if (STORE || ov.x == 0x12345678u) *(u32x4*)(Qg + ((size_t)C.hb + (size_t)C.r * L + a0 + 32 * w + row) * 64 + part * 8) = ov; }
        if ((STORE || l == 12345.678f) && h == 0) lse[((size_t)C.g * SEQ + tokq) * 8 + C.hh] = __builtin_amdgcn_logf(l) + mx;
        __syncthreads();
        if (!more) break;
        u = un;
    }
#undef AT_LOAD
}
__device__ __forceinline__ void attn_merge(Frame& F, const bf16* Og, const float* lse, bf16* Ya) {
    const int gt = F.bid * NTH + F.tid, NGT = F.G * NTH;
    for (int idx = gt; idx < SEQ * 64; idx += NGT) {
        const int e8 = idx & 7, hh = (idx >> 3) & 7, tok = idx >> 6;
        float lw[3]; float mx = -1e30f;
#pragma unroll
        for (int g = 0; g < 3; ++g) { lw[g] = lse[((size_t)g * SEQ + tok) * 8 + hh]; mx = fmaxf(mx, lw[g]); }
        float sum = 0.f;
#pragma unroll
        for (int g = 0; g < 3; ++g) { lw[g] = ex2(lw[g] - mx); sum += lw[g]; }
        const float inv = 1.0f / sum;
        float a[8] = {0.f, 0.f, 0.f, 0.f, 0.f, 0.f, 0.f, 0.f};
#pragma unroll
        for (int g = 0; g < 3; ++g) {
            const int dsh = 2 * g, sidx = ((tok & ((1 << dsh) - 1)) << (14 - dsh)) + (tok >> dsh);
            const u32x4 v = *(const u32x4*)(Og + ((size_t)(g * 8 + hh) * SEQ + sidx) * 64 + e8 * 8); const float wg = lw[g] * inv;
            a[0] += wg * bflo(v.x); a[1] += wg * bfhi(v.x); a[2] += wg * bflo(v.y); a[3] += wg * bfhi(v.y);
            a[4] += wg * bflo(v.z); a[5] += wg * bfhi(v.z); a[6] += wg * bflo(v.w); a[7] += wg * bfhi(v.w);
        }
        u32x4 o; o.x = pk2(a[0], a[1]); o.y = pk2(a[2], a[3]); o.z = pk2(a[4], a[5]); o.w = pk2(a[6], a[7]);
        *(u32x4*)(Ya + (size_t)tok * 512 + hh * 64 + e8 * 8) = o;
    }
}

__device__ __forceinline__ int swz(int row, int col) { return 256 * row + 16 * ((col >> 3) ^ (((row & 3) << 2) | ((row >> 2) & 3))) + (col & 7) * 2; }
__device__ __forceinline__ bf16x8 frag_rm_s(const LAS unsigned char* X, int row0, int k0, int lane) { return *(const LAS bf16x8*)(X + swz(row0 + (lane & 31), k0 + 8 * (lane >> 5))); }
__device__ __forceinline__ bf16x8 frag_tr_s(const LAS unsigned char* X, int k0, int col0, int lane) {
    const int G = lane >> 4, i = lane & 15, q = i >> 2, p = i & 3, h = G >> 1, row = k0 + 8 * h + q, col = col0 + 16 * (G & 1) + 4 * p;
    const s16x4 lo = tr_rd(X + swz(row, col)), hi = tr_rd(X + swz(row + 4, col));
    return (bf16x8){lo[0], lo[1], lo[2], lo[3], hi[0], hi[1], hi[2], hi[3]};
}
constexpr int T_Q = 0, T_LF = 16384, T_QR = 2 * 16384, T_KE = 3 * 16384, T_V = 4 * 16384, T_AM = 5 * 16384, AMP = 144, T_ST = T_AM + 64 * AMP, V_REF = T_ST + 32768, V_TOT = V_REF + 512, V_DEC = V_TOT + 512, H_END = V_DEC + 512;
static_assert(H_END <= LDS_BYTES - 256, "hgrn LDS map");
__device__ __forceinline__ u32x2 pack4(float a, float b, float c, float d) { u32x2 w; w.x = pk2(a, b); w.y = pk2(c, d); return w; }
template <bool OUT, bool STORE = true> __device__ __forceinline__ void hgrn_unit(Frame& F, int u, const bf16* qs, const bf16* lf, const bf16* vs, bf16* og, float* Ust, float* Dt) {
    const int tid = F.tid, lane = F.lane, w = F.wave, c31 = lane & 31, h = lane >> 5;
    const int dir = u & 1, head = (u >> 1) & 7, sc = u >> 4, colh = head * 128;
    LAS unsigned char* L = F.lds;
    LAS float* REF = (LAS float*)(L + V_REF); LAS float* TOT = (LAS float*)(L + V_TOT); LAS float* DEC = (LAS float*)(L + V_DEC);
    const int kb = w & 3, tb = w >> 2;
    const int tk = w >> 1, tvp = w & 1;
    const int tcb = w >> 2, tv = w & 3;
    const int srow = tid >> 4, spart = tid & 15;
    u32x4 rq[2], rl[2], rv[2];
#define HG_LOAD(ci_) do { const int p0_ = sc * 1024 + (ci_) * 64; _Pragma("unroll") for (int i = 0; i < 2; ++i) { const int p_ = p0_ + srow + 32 * i, t_ = dir ? (SEQ - 1 - p_) : p_; const size_t off_ = ((size_t)head * SEQ + t_) * 128 + spart * 8; \
        rl[i] = *(const u32x4*)(lf + off_); rv[i] = *(const u32x4*)(vs + off_); if (OUT) rq[i] = *(const u32x4*)(qs + off_); } } while (0)
#define HG_ST_LQ() do { _Pragma("unroll") for (int i = 0; i < 2; ++i) { *(LAS u32x4*)(L + T_LF + swz(srow + 32 * i, spart * 8)) = rl[i]; if (OUT) *(LAS u32x4*)(L + T_Q + swz(srow + 32 * i, spart * 8)) = rq[i]; } } while (0)
#define HG_ST_V() do { _Pragma("unroll") for (int i = 0; i < 2; ++i) *(LAS u32x4*)(L + T_V + swz(srow + 32 * i, spart * 8)) = rv[i]; } while (0)
    HG_LOAD(0);
    f32x16 accS[2]; accS[0] = (f32x16){}; accS[1] = (f32x16){};
    if (OUT) {
        for (int j = 0; j < sc; ++j) {
            const int uj = ((j * 8 + head) << 1) | dir;
            const float* Ub = Ust + (size_t)uj * 16384 + (32 * tk + 4 * h) * 128 + 64 * tvp + c31; const float* Db = Dt + (size_t)uj * 128 + 32 * tk + 4 * h;
            asm volatile("" : "+v"(Ub), "+v"(Db));
#pragma unroll
            for (int n = 0; n < 2; ++n)
#pragma unroll
                for (int rg = 0; rg < 16; ++rg) { const int ko = (rg & 3) + 8 * (rg >> 2); accS[n][rg] = accS[n][rg] * Db[ko] + Ub[ko * 128 + 32 * n]; }
        }
#pragma unroll
        for (int n = 0; n < 2; ++n)
#pragma unroll
            for (int gq = 0; gq < 4; ++gq)
                *(LAS u32x2*)(L + T_ST + swz(32 * (2 * tvp + n) + c31, 32 * tk + 8 * gq + 4 * h)) = pack4(accS[n][4 * gq], accS[n][4 * gq + 1], accS[n][4 * gq + 2], accS[n][4 * gq + 3]);
    }
    HG_ST_LQ(); HG_ST_V();
    __syncthreads();
    float stot[16];
#pragma unroll
    for (int rg = 0; rg < 16; ++rg) stot[rg] = 0.f;
    const int tpos = 32 * tb + c31;
    for (int ci = 0; ci < 16; ++ci) {
        const int p0 = sc * 1024 + ci * 64;
        if (ci + 1 < 16) HG_LOAD(ci + 1);
        f32x16 bacc = (f32x16){};
#pragma unroll
        for (int ks = 0; ks < 4; ++ks) {
            if (ks < 2 || tb == 1) {
                bf16x8 msk;
#pragma unroll
                for (int j = 0; j < 8; ++j) msk[j] = (16 * ks + 8 * h + j <= tpos) ? (short)0x3F80 : (short)0;
                bacc = MFMA32(frag_tr_s(L + T_LF, 16 * ks, 32 * kb, lane), msk, bacc);
            }
        }
        if (tb == 1) {
            if (OUT && c31 == 0) {
#pragma unroll
                for (int rg = 0; rg < 16; ++rg) REF[32 * kb + crow(rg, h)] = bacc[rg];
            }
            if (c31 == 31) {
#pragma unroll
                for (int rg = 0; rg < 16; ++rg) { const int k = 32 * kb + crow(rg, h); TOT[k] = bacc[rg]; DEC[k] = exn(bacc[rg]); if (!OUT) stot[rg] += bacc[rg]; }
            }
        }
        __syncthreads();
#pragma unroll
        for (int g = 0; g < 4; ++g) {
            const int k4 = 32 * kb + 8 * g + 4 * h, toff = swz(tpos, k4);
            const u32x2 lw = *(const LAS u32x2*)(L + T_LF + toff);
            const f32x4 tot4 = *(const LAS f32x4*)(TOT + k4);
            const float lfv[4] = {bflo(lw.x), bfhi(lw.x), bflo(lw.y), bfhi(lw.y)};
            float kk[4], ke[4];
#pragma unroll
            for (int i = 0; i < 4; ++i) { kk[i] = 1.0f - exn(lfv[i]); ke[i] = kk[i] * exn(tot4[i] - bacc[4 * g + i]); }
            *(LAS u32x2*)(L + T_KE + toff) = pack4(ke[0], ke[1], ke[2], ke[3]);
            if (OUT) {
                const u32x2 qw = *(const LAS u32x2*)(L + T_Q + toff);
                const f32x4 ref4 = *(const LAS f32x4*)(REF + k4);
                const float qv[4] = {bflo(qw.x), bfhi(qw.x), bflo(qw.y), bfhi(qw.y)};
                float qd[4], kd[4], qr[4];
#pragma unroll
                for (int i = 0; i < 4; ++i) { const float bb = bacc[4 * g + i]; const float x = fminf(fmaxf(bb - ref4[i], -80.f), 80.f);
                    qd[i] = qv[i] * exn(x); kd[i] = kk[i] * exn(-x); qr[i] = qv[i] * exn(bb); }
                *(LAS u32x2*)(L + T_Q + toff) = pack4(qd[0], qd[1], qd[2], qd[3]);
                *(LAS u32x2*)(L + T_LF + toff) = pack4(kd[0], kd[1], kd[2], kd[3]);
                *(LAS u32x2*)(L + T_QR + toff) = pack4(qr[0], qr[1], qr[2], qr[3]);
            }
        }
        __syncthreads();
        f32x16 acco = (f32x16){};
        if (OUT) {
#pragma unroll
            for (int ks = 0; ks < 8; ++ks) acco = MFMA32(frag_rm_s(L + T_QR, 32 * tcb, 16 * ks, lane), frag_rm_s(L + T_ST, 32 * tv, 16 * ks, lane), acco);
            if (w < 3) {
                const int ts = (w == 2) ? 1 : 0, tc = (w >= 1) ? 1 : 0; f32x16 aa = (f32x16){};
#pragma unroll
                for (int ks = 0; ks < 8; ++ks) aa = MFMA32(frag_rm_s(L + T_LF, 32 * ts, 16 * ks, lane), frag_rm_s(L + T_Q, 32 * tc, 16 * ks, lane), aa);
                const int cc = 32 * tc + c31;
#pragma unroll
                for (int gq = 0; gq < 4; ++gq) { float v4[4];
#pragma unroll
                    for (int i = 0; i < 4; ++i) { const int s = 32 * ts + 8 * gq + 4 * h + i; v4[i] = (s <= cc) ? aa[4 * gq + i] : 0.f; }
                    *(LAS u32x2*)(L + T_AM + cc * AMP + (32 * ts + 8 * gq + 4 * h) * 2) = pack4(v4[0], v4[1], v4[2], v4[3]); }
            }
            __syncthreads();
        }
        if (ci + 1 < 16) HG_ST_LQ();
        if (OUT) {
#pragma unroll
            for (int ks = 0; ks < 4; ++ks) if (ks < 2 || tcb == 1) acco = MFMA32(frag_rm(L + T_AM, AMP, 32 * tcb, 16 * ks, lane), frag_tr_s(L + T_V, 16 * ks, 32 * tv, lane), acco);
        }
        {
            float dk[16];
#pragma unroll
            for (int rg = 0; rg < 16; ++rg) dk[rg] = DEC[32 * tk + crow(rg, h)];
#pragma unroll
            for (int n = 0; n < 2; ++n) {
#pragma unroll
                for (int rg = 0; rg < 16; ++rg) accS[n][rg] *= dk[rg];
#pragma unroll
                for (int ks = 0; ks < 4; ++ks) accS[n] = MFMA32(frag_tr_s(L + T_KE, 16 * ks, 32 * tk, lane), frag_tr_s(L + T_V, 16 * ks, 32 * (2 * tvp + n), lane), accS[n]);
            }
        }
        if (OUT) {
#pragma unroll
            for (int n = 0; n < 2; ++n)
#pragma unroll
                for (int gq = 0; gq < 4; ++gq)
                    *(LAS u32x2*)(L + T_ST + swz(32 * (2 * tvp + n) + c31, 32 * tk + 8 * gq + 4 * h)) = pack4(accS[n][4 * gq], accS[n][4 * gq + 1], accS[n][4 * gq + 2], accS[n][4 * gq + 3]);
#pragma unroll
            for (int rg = 0; rg < 16; ++rg) *(LAS bf16*)(L + T_QR + swz(32 * tcb + crow(rg, h), 32 * tv + c31)) = f2bf(acco[rg]);
        }
        __syncthreads();
        if (ci + 1 < 16) HG_ST_V();
        if (OUT) {
#pragma unroll
            for (int i = 0; i < 2; ++i) { const int p = p0 + srow + 32 * i, t = dir ? (SEQ - 1 - p) : p;
                const u32x4 ov = *(const LAS u32x4*)(L + T_QR + swz(srow + 32 * i, spart * 8));
                if (STORE || ov.x == 0x12345678u) *(u32x4*)(og + ((size_t)head * SEQ + t) * 128 + spart * 8) = ov; }
        }
    }
    if (!OUT) {
        float* Uu = Ust + (size_t)u * 16384;
#pragma unroll
        for (int n = 0; n < 2; ++n)
#pragma unroll
            for (int rg = 0; rg < 16; ++rg) Uu[(32 * tk + crow(rg, h)) * 128 + 32 * (2 * tvp + n) + c31] = accS[n][rg];
        if (tb == 1 && c31 == 31) {
#pragma unroll
            for (int rg = 0; rg < 16; ++rg) Dt[(size_t)u * 128 + 32 * kb + crow(rg, h)] = exn(stot[rg]);
        }
    }
    __syncthreads();
#undef HG_LOAD
#undef HG_ST_LQ
#undef HG_ST_V
}
__device__ __forceinline__ void hgrn_combine(Frame& F, const bf16* of, const bf16* ob, const bf16* gs, const float* nw, bf16* yh) {
    const int gt = F.bid * NTH + F.tid, NGT = F.G * NTH;
    for (int idx = gt; idx < SEQ * 128; idx += NGT) {
        const int part = idx & 15, head = (idx >> 4) & 7, tok = idx >> 7; const size_t off = (size_t)tok * 1024 + head * 128 + part * 8, offh = ((size_t)head * SEQ + tok) * 128 + part * 8;
        const u32x4 a = *(const u32x4*)(of + offh), b = *(const u32x4*)(ob + offh), gg = *(const u32x4*)(gs + offh);
        float o[8] = {bflo(a.x) + bflo(b.x), bfhi(a.x) + bfhi(b.x), bflo(a.y) + bflo(b.y), bfhi(a.y) + bfhi(b.y), bflo(a.z) + bflo(b.z), bfhi(a.z) + bfhi(b.z), bflo(a.w) + bflo(b.w), bfhi(a.w) + bfhi(b.w)};
        float ss = 0.f;
#pragma unroll
        for (int i = 0; i < 8; ++i) ss += o[i] * o[i];
        ss += __shfl_xor(ss, 1); ss += __shfl_xor(ss, 2); ss += __shfl_xor(ss, 4); ss += __shfl_xor(ss, 8);
        const float r = __builtin_amdgcn_rsqf(ss * (1.0f / 128.0f) + EPS);
        const float gv[8] = {bflo(gg.x), bfhi(gg.x), bflo(gg.y), bfhi(gg.y), bflo(gg.z), bfhi(gg.z), bflo(gg.w), bfhi(gg.w)};
        const f32x4 n0 = *(const f32x4*)(nw + part * 8), n1 = *(const f32x4*)(nw + part * 8 + 4);
        const float nv[8] = {n0.x, n0.y, n0.z, n0.w, n1.x, n1.y, n1.z, n1.w};
#pragma unroll
        for (int i = 0; i < 8; ++i) o[i] = o[i] * r * nv[i] * gv[i];
        u32x4 wv; wv.x = pk2(o[0], o[1]); wv.y = pk2(o[2], o[3]); wv.z = pk2(o[4], o[5]); wv.w = pk2(o[6], o[7]);
        *(u32x4*)(yh + off) = wv;
    }
}

struct Params { const float* in[18]; float* out; unsigned char* ws; int ph_lo, ph_hi; };
constexpr int NPHASE = 17;
__global__ void __launch_bounds__(NTH, 2) mk_fwd(Params P) {
    extern __shared__ __attribute__((aligned(16))) unsigned char lds_raw[];
    Frame F;
    F.lds = (LAS unsigned char*)lds_raw;
    F.tid = threadIdx.x; F.lane = F.tid & 63; F.wave = __builtin_amdgcn_readfirstlane(F.tid >> 6); F.G = gridDim.x; F.bid = blockIdx.x;
#pragma unroll
    for (int i = 0; i < 18; ++i) F.in[i] = P.in[i];
    F.out = P.out; F.ws = P.ws;
    unsigned char* ws = P.ws;
    bf16* WFI = (bf16*)(ws + WS_WFI); bf16* WFO = (bf16*)(ws + WS_WFO); bf16* WIN = (bf16*)(ws + WS_WIN); bf16* WPA = (bf16*)(ws + WS_WPA); bf16* WPB = (bf16*)(ws + WS_WPB); bf16* WO = (bf16*)(ws + WS_WO);
    bf16* Hb = (bf16*)(ws + WS_H); bf16* ACT = (bf16*)(ws + WS_ACT); bf16* Yf = (bf16*)(ws + WS_Y); bf16* QKV = (bf16*)(ws + WS_QKV); bf16* YA = (bf16*)(ws + WS_YA);
    bf16* HG = (bf16*)(ws + WS_HG); float* LSE = (float*)(ws + WS_LSE); float* UST = (float*)(ws + WS_ST); float* DT = (float*)(ws + WS_DT);
    bf16* GA = (bf16*)(ws + WS_GA); bf16* GH = (bf16*)(ws + WS_GH); bf16* TT = (bf16*)(ws + WS_T); bf16* YM = (bf16*)(ws + WS_YM); bf16* Y2 = (bf16*)(ws + WS_Y2);
    const size_t SEC = (size_t)SEQ * 1024;
    const int lo = P.ph_lo, hi = P.ph_hi;
#if MK_SINGLE
    if (F.tid < 64) ((LAS unsigned*)(F.lds + MISC_OFF))[F.tid] = 0u;
    __syncthreads();
    XcdBarrier bar = xcd_barrier_post((unsigned*)ws, (volatile LAS unsigned*)(F.lds + MISC_OFF));
#define SEAM(k) do { if (lo <= (k) && (k) + 1 < hi) xcd_barrier(bar); } while (0)
#else
#define SEAM(k) do { } while (0)
#endif
#define IN(k) (lo <= (k) && (k) < hi)
#ifndef MK_DOUBLE
#define MK_DOUBLE 0
#endif
#define REPS(k) ((((MK_DOUBLE) >> (k)) & 1) ? 2 : 1)
#define REP_BEGIN(k) for (int rep_ = 0; rep_ < REPS(k); ++rep_) {
#if MK_SINGLE
#define REP_END(k) if (rep_ + 1 < REPS(k)) xcd_barrier(bar); }
#else
#define REP_END(k) }
#endif

    if (IN(0)) { REP_BEGIN(0)
        { const ConvJob jobs[2] = {{F.in[2], WFI, DM, 2 * DFF, 1, (DM / 64) * (2 * DFF / 64)}, {F.in[3], WFO, DFF, DM, 0, (DFF / 64) * (DM / 64)}};
          convert_weights<2>(F, jobs, F.bid * NWAVES + F.wave, F.G * NWAVES); }
        row_pass(F, F.in[0], nullptr, 0.f, nullptr, nullptr, F.in[1], Hb);
        __syncthreads();
        REP_END(0) SEAM(0);
    }
    if (IN(1)) { REP_BEGIN(1)
        pg8::Gemm g{Hb, WFI, SEQ, 2 * DFF, DM}; pg8::StaticOrder S; S.init(SEQ, 2 * DFF, F.G, F.bid);
        pg8::EpiSwiglu E{ACT, DFF};
        pg8::gemm_phase<pg8::EpiSwiglu, pg8::StaticOrder, true, true>(F.lds, g, S, E);
        { const int busy = (SEQ / 256) * (2 * DFF / 256) - ((SEQ / 256) * (2 * DFF / 256) / F.G) * F.G;
          if (busy > 0 && busy < F.G && F.bid >= busy) {
            const ConvJob jobs[4] = {{F.in[6], WIN, DM, INW, 0, (DM / 64) * (INW / 64)}, {F.in[10], WPA, 512, DM, 0, (512 / 64) * (DM / 64)}, {F.in[11], WPB, DM, DM, 0, (DM / 64) * (DM / 64)}, {F.in[12], WO, DM, DM, 0, (DM / 64) * (DM / 64)}};
            convert_weights<4>(F, jobs, (F.bid - busy) * NWAVES + F.wave, (F.G - busy) * NWAVES); __syncthreads(); }
          else if (!(busy > 0 && busy < F.G)) {
            const ConvJob jobs[4] = {{F.in[6], WIN, DM, INW, 0, (DM / 64) * (INW / 64)}, {F.in[10], WPA, 512, DM, 0, (512 / 64) * (DM / 64)}, {F.in[11], WPB, DM, DM, 0, (DM / 64) * (DM / 64)}, {F.in[12], WO, DM, DM, 0, (DM / 64) * (DM / 64)}};
            convert_weights<4>(F, jobs, F.bid * NWAVES + F.wave, F.G * NWAVES); __syncthreads(); } }
        REP_END(1) SEAM(1);
    }
    if (IN(2)) { REP_BEGIN(2)
        pg8::Gemm g{ACT, WFO, SEQ, DM, DFF}; pg8::StaticOrder S; S.init(SEQ, DM, F.G, F.bid);
        pg8::EpiSect<3> E{Yf, 1024, 0, 1.f, nullptr};
        pg8::gemm_phase<pg8::EpiSect<3>, pg8::StaticOrder, true, true>(F.lds, g, S, E);
        REP_END(2) SEAM(2);
    }
    if (IN(3)) { REP_BEGIN(3)
        row_pass(F, F.in[0], Yf, 0.5f, F.in[4], F.out, F.in[5], Hb);
        __syncthreads();
        REP_END(3) SEAM(3);
    }
    if (IN(4)) { REP_BEGIN(4)
        pg8::Gemm g{Hb, WIN, SEQ, 4608, DM}; pg8::StaticOrder S; S.init(SEQ, 4608, F.G, F.bid);
        pg8::EpiSect<0> E{QKV, 1536, (size_t)SEQ * 1536, 0.125f * LOG2E, nullptr};
        pg8::gemm_phase<pg8::EpiSect<0>, pg8::StaticOrder, true, true>(F.lds, g, S, E);
        { const int busy = (SEQ / 256) * (4608 / 256) - ((SEQ / 256) * (4608 / 256) / F.G) * F.G;
          const ConvJob jobs[2] = {{F.in[15], WFI, DM, 2 * DFF, 1, (DM / 64) * (2 * DFF / 64)}, {F.in[16], WFO, DFF, DM, 0, (DFF / 64) * (DM / 64)}};
          if (busy > 0 && busy < F.G) { if (F.bid >= busy) { convert_weights<2>(F, jobs, (F.bid - busy) * NWAVES + F.wave, (F.G - busy) * NWAVES); __syncthreads(); } }
          else { convert_weights<2>(F, jobs, F.bid * NWAVES + F.wave, F.G * NWAVES); __syncthreads(); } }
        REP_END(4) SEAM(4);
    }
    if (IN(5)) {
#if defined(MK_PRE) && (MK_PRE & 1)
        attn_phase<false>(F, QKV, QKV + (size_t)SEQ * 1536, QKV + (size_t)2 * SEQ * 1536, F.in[7], LSE); xcd_barrier(bar);
#endif
        attn_phase<true>(F, QKV, QKV + (size_t)SEQ * 1536, QKV + (size_t)2 * SEQ * 1536, F.in[7], LSE);
        SEAM(5);
    }
    if (IN(6)) { REP_BEGIN(6) attn_merge(F, QKV, LSE, YA); REP_END(6) SEAM(6); }
    if (IN(7)) { REP_BEGIN(7)
        pg8::Gemm g{Hb, WIN + (size_t)4608 * DM, SEQ, 5120, DM}; pg8::StaticOrder S; S.init(SEQ, 5120, F.G, F.bid);
        pg8::EpiSect<1> E{HG, 1024, SEC, 1.f, F.in[8]};
        pg8::gemm_phase<pg8::EpiSect<1>, pg8::StaticOrder, true, true>(F.lds, g, S, E);
        REP_END(7) SEAM(7);
    }
    if (IN(8)) { REP_BEGIN(8)
        for (int u = F.bid; u < 256; u += F.G) hgrn_unit<false>(F, u, HG, HG + ((u & 1) ? 2 : 1) * SEC, HG + 3 * SEC, nullptr, UST, DT);
        REP_END(8) SEAM(8);
    }
    if (IN(9)) {
#if defined(MK_PRE) && (MK_PRE & 2)
        for (int u = F.bid; u < 256; u += F.G) { bf16* lfp = HG + ((u & 1) ? 2 : 1) * SEC; hgrn_unit<true, false>(F, u, HG, lfp, HG + 3 * SEC, lfp, UST, DT); }
        xcd_barrier(bar);
#endif
        for (int u = F.bid; u < 256; u += F.G) { bf16* lfp = HG + ((u & 1) ? 2 : 1) * SEC; hgrn_unit<true>(F, u, HG, lfp, HG + 3 * SEC, lfp, UST, DT); }
        SEAM(9);
    }
    if (IN(10)) { REP_BEGIN(10) hgrn_combine(F, HG + SEC, HG + 2 * SEC, HG + 4 * SEC, F.in[9], HG); REP_END(10) SEAM(10); }
    if (IN(11)) { REP_BEGIN(11)
        pg8::StaticOrder S; S.init(SEQ, DM, F.G, F.bid);
        { pg8::Gemm g{Hb, WIN + (size_t)9728 * DM, SEQ, DM, DM}; pg8::EpiSect<2> E{GA, 1024, 0, 1.f, nullptr}; pg8::gemm_phase<pg8::EpiSect<2>, pg8::StaticOrder, true, true>(F.lds, g, S, E); }
        { pg8::Gemm g{YA, WPA, SEQ, DM, 512}; pg8::EpiGated<false> E{TT, GA, nullptr, DM}; pg8::gemm_phase<pg8::EpiGated<false>, pg8::StaticOrder, true, true>(F.lds, g, S, E); }
        { pg8::Gemm g{Hb, WIN + (size_t)10752 * DM, SEQ, DM, DM}; pg8::EpiSect<2> E{GH, 1024, 0, 1.f, nullptr}; pg8::gemm_phase<pg8::EpiSect<2>, pg8::StaticOrder, true, true>(F.lds, g, S, E); }
        { pg8::Gemm g{HG, WPB, SEQ, DM, DM}; pg8::EpiGated<true> E{YM, GH, TT, DM}; pg8::gemm_phase<pg8::EpiGated<true>, pg8::StaticOrder, true, true>(F.lds, g, S, E); }
        REP_END(11) SEAM(11);
    }
    if (IN(12)) { REP_BEGIN(12)
        pg8::Gemm g{YM, WO, SEQ, DM, DM}; pg8::StaticOrder S; S.init(SEQ, DM, F.G, F.bid);
        pg8::EpiSect<3> E{Y2, 1024, 0, 1.f, nullptr};
        pg8::gemm_phase<pg8::EpiSect<3>, pg8::StaticOrder, true, true>(F.lds, g, S, E);
        REP_END(12) SEAM(12);
    }
    if (IN(13)) { row_pass(F, F.out, Y2, 1.0f, F.in[13], F.out, F.in[14], Hb); SEAM(13); }
    if (IN(14)) { REP_BEGIN(14)
        pg8::Gemm g{Hb, WFI, SEQ, 2 * DFF, DM}; pg8::StaticOrder S; S.init(SEQ, 2 * DFF, F.G, F.bid);
        pg8::EpiSwiglu E{ACT, DFF};
        pg8::gemm_phase<pg8::EpiSwiglu, pg8::StaticOrder, true, true>(F.lds, g, S, E);
        REP_END(14) SEAM(14);
    }
    if (IN(15)) { REP_BEGIN(15)
        pg8::Gemm g{ACT, WFO, SEQ, DM, DFF}; pg8::StaticOrder S; S.init(SEQ, DM, F.G, F.bid);
        pg8::EpiSect<3> E{Yf, 1024, 0, 1.f, nullptr};
        pg8::gemm_phase<pg8::EpiSect<3>, pg8::StaticOrder, true, true>(F.lds, g, S, E);
        REP_END(15) SEAM(15);
    }
    if (IN(16)) { row_pass(F, F.out, Yf, 0.5f, F.in[17], F.out, nullptr, nullptr); }
#ifdef MK_EXTRA
    xcd_barrier(bar);
#if MK_EXTRA & 1
    attn_phase<true>(F, QKV, QKV + (size_t)SEQ * 1536, QKV + (size_t)2 * SEQ * 1536, F.in[7], LSE);
    xcd_barrier(bar);
#endif
#if MK_EXTRA & 2
    for (int u = F.bid; u < 256; u += F.G) hgrn_unit<false>(F, u, HG, HG + ((u & 1) ? 2 : 1) * SEC, HG + 3 * SEC, nullptr, UST, DT);
    xcd_barrier(bar);
#endif
#if MK_EXTRA & 4
    for (int u = F.bid; u < 256; u += F.G) { bf16* lfp = HG + ((u & 1) ? 2 : 1) * SEC; hgrn_unit<true>(F, u, HG, lfp, HG + 3 * SEC, lfp, UST, DT); }
    xcd_barrier(bar);
#endif
#if MK_EXTRA & 8
    attn_merge(F, QKV, LSE, YA); xcd_barrier(bar);
    hgrn_combine(F, HG + SEC, HG + 2 * SEC, HG + 4 * SEC, F.in[9], HG); xcd_barrier(bar);
#endif
#if MK_EXTRA & 16
    xcd_barrier(bar);
#endif
#if MK_EXTRA & 64
    { pg8::StaticOrder S; S.init(SEQ, DM, F.G, F.bid);
      { pg8::Gemm g{Hb, WIN + (size_t)9728 * DM, SEQ, DM, DM}; pg8::EpiSect<2> E{GA, 1024, 0, 1.f, nullptr}; pg8::gemm_phase<pg8::EpiSect<2>, pg8::StaticOrder, true, true>(F.lds, g, S, E); }
      { pg8::Gemm g{YA, WPA, SEQ, DM, 512}; pg8::EpiGated<false> E{TT, GA, nullptr, DM}; pg8::gemm_phase<pg8::EpiGated<false>, pg8::StaticOrder, true, true>(F.lds, g, S, E); }
      { pg8::Gemm g{Hb, WIN + (size_t)10752 * DM, SEQ, DM, DM}; pg8::EpiSect<2> E{GH, 1024, 0, 1.f, nullptr}; pg8::gemm_phase<pg8::EpiSect<2>, pg8::StaticOrder, true, true>(F.lds, g, S, E); }
      { pg8::Gemm g{HG, WPB, SEQ, DM, DM}; pg8::EpiGated<true> E{YM, GH, TT, DM}; pg8::gemm_phase<pg8::EpiGated<true>, pg8::StaticOrder, true, true>(F.lds, g, S, E); }
      xcd_barrier(bar); }
#endif
#if MK_EXTRA & 32
    row_pass(F, F.in[0], Yf, 0.5f, F.in[4], (float*)(ws + WS_BIG), F.in[5], Hb); xcd_barrier(bar);
#endif
#endif
#undef IN
#undef SEAM
}

extern "C" void kernel_launch(void* const* d_in, const int* in_sizes, int n_in, void* d_out, int out_size, void* d_ws, size_t ws_size, hipStream_t stream) {
    static int grid = 0;
    if (grid == 0) {
        if (n_in != 18 || out_size != SEQ * DM || ws_size < WS_END) { fprintf(stderr, "kernel_launch: unexpected shapes (n_in %d out %d ws %zu)\n", n_in, out_size, ws_size); grid = -1; return; }
        int dev = 0, cus = 0, per_cu = 0;
        if (hipGetDevice(&dev) != hipSuccess || hipDeviceGetAttribute(&cus, hipDeviceAttributeMultiprocessorCount, dev) != hipSuccess) { grid = -1; return; }
        if (hipFuncSetAttribute((const void*)mk_fwd, hipFuncAttributeMaxDynamicSharedMemorySize, LDS_BYTES) != hipSuccess) { fprintf(stderr, "kernel_launch: hipFuncSetAttribute failed\n"); grid = -1; return; }
        if (hipOccupancyMaxActiveBlocksPerMultiprocessor(&per_cu, (const void*)mk_fwd, NTH, LDS_BYTES) != hipSuccess || per_cu < 1) { fprintf(stderr, "kernel_launch: occupancy query says %d\n", per_cu); per_cu = 1; }
        (void)hipGetLastError();
        grid = cus;
    }
    if (grid < 0) return;
    Params p{};
    for (int i = 0; i < 18; ++i) p.in[i] = (const float*)d_in[i];
    p.out = (float*)d_out; p.ws = (unsigned char*)d_ws;
#if MK_SINGLE
    p.ph_lo = 0; p.ph_hi = NPHASE;
    if (hipMemsetAsync(d_ws, 0, CTL_ZERO_BYTES, stream) != hipSuccess) { fprintf(stderr, "kernel_launch: memset failed\n"); return; }
    void* args[] = {&p};
    hipError_t e = hipLaunchCooperativeKernel((const void*)mk_fwd, dim3(grid), dim3(NTH), args, LDS_BYTES, stream);
    if (e != hipSuccess) fprintf(stderr, "cooperative launch failed: %s (grid %d)\n", hipGetErrorString(e), grid);
#else
    for (int ph = 0; ph < NPHASE; ++ph) { p.ph_lo = ph; p.ph_hi = ph + 1; hipLaunchKernelGGL(mk_fwd, dim3(grid), dim3(NTH), LDS_BYTES, stream, p); }
#endif
}
```
